# Optimizing an MI355X kernel written in HIP

```python
import jax, jax.numpy as jnp
from jax import lax
import numpy as np

D_MODEL = 1024
BATCH = 8
SEQ = 4096
DEPTH = 4

N_GROUPS = 4
GROUP_WIDTH = D_MODEL // N_GROUPS
D_MIX = N_GROUPS * GROUP_WIDTH
CONV_KERNEL = 31
MLA_HEADS = 4
MLA_NOPE = 64
MLA_ROPE = 32
MLA_V = GROUP_WIDTH // MLA_HEADS
MLA_Q_RANK = 192
MLA_KV_RANK = 128
ROPE_BASE = 10000.0
ATTN_BLOCK = 128
POOL_WINDOWS = (2, 4, 8, 16)
POOL_CH = GROUP_WIDTH // len(POOL_WINDOWS)
GMLP_HEADS = 4
GMLP_HEAD_DIM = GROUP_WIDTH // GMLP_HEADS
GMLP_CHUNK = 128
D_FF = 4 * D_MODEL
NORM_EPS = 1e-6

D_CONV_IN = 2 * GROUP_WIDTH
D_MLA_IN = MLA_Q_RANK + MLA_KV_RANK + MLA_ROPE
D_POOL_IN = GROUP_WIDTH
D_GMLP_IN = 2 * GROUP_WIDTH
D_IN = D_CONV_IN + D_MLA_IN + D_POOL_IN + D_GMLP_IN

kernel_name = "hybrid_parallel_head_group_trunk"


def rms_norm(x, g):
    xf = x.astype(jnp.float32)
    y = xf * lax.rsqrt(jnp.mean(xf * xf, axis=-1, keepdims=True) + NORM_EPS)
    return (y * g.astype(jnp.float32)).astype(x.dtype)


def layer_norm(x, g, b):
    xf = x.astype(jnp.float32)
    mu = jnp.mean(xf, axis=-1, keepdims=True)
    var = jnp.mean(jnp.square(xf - mu), axis=-1, keepdims=True)
    y = (xf - mu) * lax.rsqrt(var + NORM_EPS)
    return (y * g.astype(jnp.float32) + b.astype(jnp.float32)).astype(x.dtype)


def rope_tables(positions):
    inv_freq = ROPE_BASE ** (-jnp.arange(0, MLA_ROPE, 2, dtype=jnp.float32) / MLA_ROPE)
    ang = positions.astype(jnp.float32)[..., None] * inv_freq
    return jnp.cos(ang), jnp.sin(ang)


def apply_rope(x, cos, sin):
    xf = x.astype(jnp.float32)
    x1, x2 = jnp.split(xf, 2, axis=-1)
    return jnp.concatenate([x1 * cos - x2 * sin, x2 * cos + x1 * sin], axis=-1).astype(x.dtype)


def conv_module(z, dw_w, dw_b, ln_g, ln_b, pw_w):
    a, g = jnp.split(z, 2, axis=-1)
    y = a * jax.nn.sigmoid(g)
    y = lax.conv_general_dilated(
        y, dw_w[:, None, :], window_strides=(1,), padding=[(CONV_KERNEL - 1, 0)],
        dimension_numbers=('NWC', 'WIO', 'NWC'), feature_group_count=GROUP_WIDTH) + dw_b
    y = jax.nn.silu(layer_norm(y, ln_g, ln_b))
    return y @ pw_w


def causal_block_attention(q, k, v):
    b, s, h, dk = q.shape
    n_blk = s // ATTN_BLOCK
    scale = dk ** -0.5
    q_blocks = q.reshape(b, n_blk, ATTN_BLOCK, h, dk).transpose(1, 0, 2, 3, 4)
    key_pos = jnp.arange(s)

    def attend(args):
        q_blk, blk = args
        scores = jnp.einsum('bqhd,bkhd->bhqk', q_blk, k).astype(jnp.float32) * scale
        query_pos = blk * ATTN_BLOCK + jnp.arange(ATTN_BLOCK)
        mask = key_pos[None, :] <= query_pos[:, None]
        probs = jax.nn.softmax(jnp.where(mask, scores, -jnp.inf), axis=-1).astype(v.dtype)
        return jnp.einsum('bhqk,bkhd->bqhd', probs, v)

    out = lax.map(attend, (q_blocks, jnp.arange(n_blk)))
    return out.transpose(1, 0, 2, 3, 4).reshape(b, s, h, v.shape[-1])


def latent_attention(z, cos, sin, q_norm_g, w_uq, kv_norm_g, w_ukv):
    b, s, _ = z.shape
    c_q, c_kv, k_rope = jnp.split(z, (MLA_Q_RANK, MLA_Q_RANK + MLA_KV_RANK), axis=-1)
    q = (rms_norm(c_q, q_norm_g) @ w_uq).reshape(b, s, MLA_HEADS, MLA_NOPE + MLA_ROPE)
    kv = (rms_norm(c_kv, kv_norm_g) @ w_ukv).reshape(b, s, MLA_HEADS, MLA_NOPE + MLA_V)
    q_nope, q_rope = jnp.split(q, (MLA_NOPE,), axis=-1)
    k_nope, v = jnp.split(kv, (MLA_NOPE,), axis=-1)
    q_rope = apply_rope(q_rope, cos[:, :, None, :], sin[:, :, None, :])
    k_rope = apply_rope(k_rope, cos, sin)[:, :, None, :]
    q = jnp.concatenate([q_nope, q_rope], axis=-1)
    k = jnp.concatenate([k_nope, jnp.broadcast_to(k_rope, (b, s, MLA_HEADS, MLA_ROPE))], axis=-1)
    return causal_block_attention(q, k, v).reshape(b, s, MLA_HEADS * MLA_V)


def multiscale_pool(z, pool_w, pool_scale):
    b, s, c = z.shape
    zf = z.astype(jnp.float32)
    csum = jnp.concatenate([jnp.zeros((b, 1, c), jnp.float32), jnp.cumsum(zf, axis=1)], axis=1)
    t = jnp.arange(s)
    outs = []
    for g, w in enumerate(POOL_WINDOWS):
        sl = slice(g * POOL_CH, (g + 1) * POOL_CH)
        lo = jnp.maximum(t + 1 - w, 0)
        win_sum = csum[:, 1:, sl] - csum[:, lo, sl]
        count = jnp.minimum(t + 1, w).astype(jnp.float32)
        y = win_sum / count[None, :, None] - zf[..., sl]
        outs.append(jnp.einsum('bsc,cd->bsd', y, pool_w[g].astype(jnp.float32)))
    return (jnp.concatenate(outs, axis=-1) * pool_scale.astype(jnp.float32)).astype(z.dtype)


def spatial_gating(z, norm_g, ws, bs):
    b, s, _ = z.shape
    u, v = jnp.split(z, 2, axis=-1)
    v = rms_norm(v, norm_g).reshape(b, s // GMLP_CHUNK, GMLP_CHUNK, GMLP_HEADS, GMLP_HEAD_DIM)
    causal = jnp.tril(jnp.ones((GMLP_CHUNK, GMLP_CHUNK), dtype=ws.dtype))
    gate = jnp.einsum('hij,bnjhd->bnihd', ws * causal, v) + bs.T[None, None, :, :, None]
    return u * gate.reshape(b, s, GROUP_WIDTH)


def setup_inputs(seed: int = 0) -> dict:
    key = jax.random.key(seed)
    ks = jax.random.split(key, 24)

    def normal(k, shape, scale):
        return jax.random.normal(k, shape, jnp.float32) * scale

    def gain(k, shape):
        return 1.0 + normal(k, shape, 0.05)

    positions = (jnp.arange(SEQ, dtype=jnp.int32)[None, :]
                 + jax.random.randint(ks[1], (BATCH, 1), 0, 1024, dtype=jnp.int32))
    return {
        'x': normal(ks[0], (BATCH, SEQ, D_MODEL), 1.0),
        'positions': positions,
        'mix_norm_g': gain(ks[2], (DEPTH, D_MODEL)),
        'w_in': normal(ks[3], (DEPTH, D_MODEL, D_IN), D_MODEL ** -0.5),
        'conv_dw_w': normal(ks[4], (DEPTH, CONV_KERNEL, GROUP_WIDTH), CONV_KERNEL ** -0.5),
        'conv_dw_b': normal(ks[5], (DEPTH, GROUP_WIDTH), 0.02),
        'conv_ln_g': gain(ks[6], (DEPTH, GROUP_WIDTH)),
        'conv_ln_b': normal(ks[7], (DEPTH, GROUP_WIDTH), 0.02),
        'conv_pw_w': normal(ks[8], (DEPTH, GROUP_WIDTH, GROUP_WIDTH), GROUP_WIDTH ** -0.5),
        'mla_q_norm_g': gain(ks[9], (DEPTH, MLA_Q_RANK)),
        'mla_w_uq': normal(ks[10], (DEPTH, MLA_Q_RANK, MLA_HEADS * (MLA_NOPE + MLA_ROPE)), MLA_Q_RANK ** -0.5),
        'mla_kv_norm_g': gain(ks[11], (DEPTH, MLA_KV_RANK)),
        'mla_w_ukv': normal(ks[12], (DEPTH, MLA_KV_RANK, MLA_HEADS * (MLA_NOPE + MLA_V)), MLA_KV_RANK ** -0.5),
        'pool_w': normal(ks[13], (DEPTH, len(POOL_WINDOWS), POOL_CH, POOL_CH), POOL_CH ** -0.5),
        'pool_scale': gain(ks[14], (DEPTH, GROUP_WIDTH)),
        'gmlp_norm_g': gain(ks[15], (DEPTH, GROUP_WIDTH)),
        'gmlp_ws': normal(ks[16], (DEPTH, GMLP_HEADS, GMLP_CHUNK, GMLP_CHUNK), GMLP_CHUNK ** -0.5),
        'gmlp_bs': 1.0 + normal(ks[17], (DEPTH, GMLP_HEADS, GMLP_CHUNK), 0.1),
        'group_norm_g': gain(ks[18], (DEPTH, N_GROUPS, GROUP_WIDTH)),
        'w_out': normal(ks[19], (DEPTH, D_MIX, D_MODEL), D_MIX ** -0.5),
        'ffn_norm_g': gain(ks[20], (DEPTH, D_MODEL)),
        'w_ff1': normal(ks[21], (DEPTH, D_MODEL, D_FF), D_MODEL ** -0.5),
        'w_ff2': normal(ks[22], (DEPTH, D_FF, D_MODEL), D_FF ** -0.5),
        'final_norm_g': gain(ks[23], (D_MODEL,)),
    }


def reference(x, positions, mix_norm_g, w_in, conv_dw_w, conv_dw_b, conv_ln_g, conv_ln_b, conv_pw_w,
              mla_q_norm_g, mla_w_uq, mla_kv_norm_g, mla_w_ukv, pool_w, pool_scale,
              gmlp_norm_g, gmlp_ws, gmlp_bs, group_norm_g, w_out, ffn_norm_g, w_ff1, w_ff2,
              final_norm_g):
    cos, sin = rope_tables(positions)
    split_at = (D_CONV_IN, D_CONV_IN + D_MLA_IN, D_CONV_IN + D_MLA_IN + D_POOL_IN)
    h = x
    for l in range(DEPTH):
        z = rms_norm(h, mix_norm_g[l]) @ w_in[l]
        z_conv, z_mla, z_pool, z_gmlp = jnp.split(z, split_at, axis=-1)
        o_conv = conv_module(z_conv, conv_dw_w[l], conv_dw_b[l], conv_ln_g[l], conv_ln_b[l], conv_pw_w[l])
        o_mla = latent_attention(z_mla, cos, sin, mla_q_norm_g[l], mla_w_uq[l], mla_kv_norm_g[l], mla_w_ukv[l])
        o_pool = multiscale_pool(z_pool, pool_w[l], pool_scale[l])
        o_gmlp = spatial_gating(z_gmlp, gmlp_norm_g[l], gmlp_ws[l], gmlp_bs[l])
        mixed = jnp.concatenate([rms_norm(o_conv, group_norm_g[l, 0]), rms_norm(o_mla, group_norm_g[l, 1]),
                                 rms_norm(o_pool, group_norm_g[l, 2]), rms_norm(o_gmlp, group_norm_g[l, 3])],
                                axis=-1)
        h = h + mixed @ w_out[l]
        f = jnp.square(jax.nn.relu(rms_norm(h, ffn_norm_g[l]) @ w_ff1[l]))
        h = h + f @ w_ff2[l]
    return rms_norm(h, final_norm_g)
```

```cpp
#include <hip/hip_runtime.h>
#include <hip/hip_cooperative_groups.h>
#include <cstdio>
namespace cg = cooperative_groups;
#ifndef DUP_MASK
#define DUP_MASK 0
#endif
#ifndef MIX_MASK
#define MIX_MASK 15
#endif
#ifndef PH_MASK
#define PH_MASK 127
#endif

#define LAS __attribute__((address_space(3)))
typedef unsigned short bf16_t;
typedef short bf16x8 __attribute__((ext_vector_type(8)));
typedef short bf16x4 __attribute__((ext_vector_type(4)));
typedef float f32x4 __attribute__((ext_vector_type(4)));
typedef float f32x2 __attribute__((ext_vector_type(2)));
typedef float f32x16 __attribute__((ext_vector_type(16)));
typedef unsigned u32x4 __attribute__((ext_vector_type(4)));
typedef unsigned u32x2 __attribute__((ext_vector_type(2)));

constexpr int M_TOK = 32768, DM = 1024, SEQ = 4096, DEPTH = 4;
constexpr int DIN = 1632, DIN_P = 1792, DFF = 4096;
constexpr int ZC_G = 256, ZC_CQ = 512, ZC_CKV = 704, ZC_KR = 832, ZC_POOL = 864, ZC_U = 1120, ZC_V = 1376;
constexpr float EPS = 1e-6f;
constexpr float QSCALE = 0.14724444602590306f;

__constant__ float INV_FREQ[16] = {1.000000000e+00f, 5.623413324e-01f, 3.162277639e-01f, 1.778279394e-01f, 1.000000015e-01f, 5.623413250e-02f, 3.162277490e-02f, 1.778279431e-02f,
                                   9.999999776e-03f, 5.623413250e-03f, 3.162277630e-03f, 1.778279431e-03f, 1.000000047e-03f, 5.623413017e-04f, 3.162277571e-04f, 1.778279402e-04f};

constexpr size_t SZ_WIN = (size_t)DIN_P * DM * 2, SZ_WOUT = (size_t)DM * DM * 2, SZ_W1 = (size_t)DFF * DM * 2, SZ_W2 = SZ_W1;
constexpr size_t SZ_PW = 256 * 256 * 2, SZ_UQ = 384 * 192 * 2, SZ_UKV = 512 * 128 * 2, SZ_POOL = 4 * 64 * 64 * 2, SZ_GWS = 4 * 128 * 128 * 2;
constexpr size_t OFF_WIN = 0;
constexpr size_t OFF_WOUT = OFF_WIN + DEPTH * SZ_WIN;
constexpr size_t OFF_W1 = OFF_WOUT + DEPTH * SZ_WOUT;
constexpr size_t OFF_W2 = OFF_W1 + DEPTH * SZ_W1;
constexpr size_t OFF_PW = OFF_W2 + DEPTH * SZ_W2;
constexpr size_t OFF_UQ = OFF_PW + DEPTH * SZ_PW;
constexpr size_t OFF_UKV = OFF_UQ + DEPTH * SZ_UQ;
constexpr size_t OFF_POOL = OFF_UKV + DEPTH * SZ_UKV;
constexpr size_t OFF_GWS = OFF_POOL + DEPTH * SZ_POOL;
constexpr size_t OFF_HB = OFF_GWS + DEPTH * SZ_GWS;
constexpr size_t OFF_SSQA = OFF_HB + (size_t)M_TOK * DM * 2;
constexpr size_t OFF_SSQF = OFF_SSQA + (size_t)M_TOK * 16 * 4;
constexpr size_t OFF_SSQM = OFF_SSQF + (size_t)M_TOK * 16 * 4;
constexpr size_t OFF_ROPE = OFF_SSQM + (size_t)M_TOK * 4 * 4;
constexpr size_t OFF_UNION = OFF_ROPE + (size_t)M_TOK * 32 * 4;
constexpr size_t OFF_ZB = OFF_UNION;
constexpr size_t OFF_MIX = OFF_ZB + (size_t)M_TOK * DIN_P * 2;
constexpr size_t OFF_Q = OFF_MIX + (size_t)M_TOK * DM * 2;
constexpr size_t OFF_K = OFF_Q + (size_t)M_TOK * 384 * 2;
constexpr size_t OFF_VT = OFF_K + (size_t)M_TOK * 384 * 2;
constexpr size_t OFF_FB = OFF_UNION;
constexpr size_t WS_END = OFF_UNION + (size_t)M_TOK * DFF * 2;
constexpr size_t OFF_BAR = WS_END;
constexpr size_t WS_TOTAL = WS_END + 512;
static_assert(OFF_VT + (size_t)M_TOK * 256 * 2 <= WS_END, "union overflow");
static_assert(OFF_HB % 256 == 0 && OFF_UNION % 256 == 0, "align");

constexpr int LDS_BYTES = 163840;

struct Params;
typedef const __attribute__((address_space(4))) Params* KP;
struct Params {
    const float* x; const int* positions; const float* mix_norm_g; const float* w_in; const float* conv_dw_w; const float* conv_dw_b; const float* conv_ln_g; const float* conv_ln_b;
    const float* conv_pw_w; const float* mla_q_norm_g; const float* mla_w_uq; const float* mla_kv_norm_g; const float* mla_w_ukv; const float* pool_w; const float* pool_scale;
    const float* gmlp_norm_g; const float* gmlp_ws; const float* gmlp_bs; const float* group_norm_g; const float* w_out; const float* ffn_norm_g; const float* w_ff1; const float* w_ff2;
    const float* final_norm_g;
    float* out; unsigned char* ws;
    int ph_lo, ph_hi;
};

__device__ __forceinline__ unsigned pk2(float lo, float hi) { unsigned r; asm("v_cvt_pk_bf16_f32 %0, %1, %2" : "=v"(r) : "v"(lo), "v"(hi)); return r; }
__device__ __forceinline__ float bf_lo(unsigned w) { return __uint_as_float(w << 16); }
__device__ __forceinline__ float bf_hi(unsigned w) { return __uint_as_float(w & 0xffff0000u); }
__device__ __forceinline__ float wave_sum(float v) {
#pragma unroll
    for (int o = 1; o < 64; o <<= 1) v += __shfl_xor(v, o);
    return v;
}
__device__ __forceinline__ f32x4 mfma16(bf16x8 a, bf16x8 b, f32x4 c) { return __builtin_amdgcn_mfma_f32_16x16x32_bf16(a, b, c, 0, 0, 0); }
__device__ __forceinline__ f32x16 mfma32(bf16x8 a, bf16x8 b, f32x16 c) { return __builtin_amdgcn_mfma_f32_32x32x16_bf16(a, b, c, 0, 0, 0); }
__device__ __forceinline__ float fast_rcp(float x) { return __builtin_amdgcn_rcpf(x); }
__device__ __forceinline__ float fast_exp2(float x) { return __builtin_amdgcn_exp2f(x); }
__device__ __forceinline__ float sigmoidf_(float x) { return fast_rcp(1.0f + fast_exp2(-1.4426950408889634f * x)); }
__device__ __forceinline__ float sumsq8(u32x4 v) {
    float s = 0.f;
#pragma unroll
    for (int i = 0; i < 4; ++i) { const float a = bf_lo(v[i]), b = bf_hi(v[i]); s += a * a + b * b; }
    return s;
}
__device__ __forceinline__ bf16x8 as_bf16x8(u32x4 v) { return __builtin_bit_cast(bf16x8, v); }

template <int N> __device__ __forceinline__ void pin(u32x4 (&b)[N]) {
    static_assert(N == 2 || N == 4 || N == 5 || N == 6 || N == 8 || N == 16, "pin size");
    if constexpr (N == 2) asm volatile("" : "+v"(b[0]), "+v"(b[1]));
    else if constexpr (N == 4) asm volatile("" : "+v"(b[0]), "+v"(b[1]), "+v"(b[2]), "+v"(b[3]));
    else if constexpr (N == 5) asm volatile("" : "+v"(b[0]), "+v"(b[1]), "+v"(b[2]), "+v"(b[3]), "+v"(b[4]));
    else if constexpr (N == 6) asm volatile("" : "+v"(b[0]), "+v"(b[1]), "+v"(b[2]), "+v"(b[3]), "+v"(b[4]), "+v"(b[5]));
    else if constexpr (N == 8) asm volatile("" : "+v"(b[0]), "+v"(b[1]), "+v"(b[2]), "+v"(b[3]), "+v"(b[4]), "+v"(b[5]), "+v"(b[6]), "+v"(b[7]));
    else asm volatile("" : "+v"(b[0]), "+v"(b[1]), "+v"(b[2]), "+v"(b[3]), "+v"(b[4]), "+v"(b[5]), "+v"(b[6]), "+v"(b[7]), "+v"(b[8]), "+v"(b[9]), "+v"(b[10]), "+v"(b[11]), "+v"(b[12]), "+v"(b[13]), "+v"(b[14]), "+v"(b[15]));
}
template <int N> __device__ __forceinline__ void ldfr(u32x4 (&b)[N], const bf16_t* ptr) {
#pragma unroll
    for (int ks = 0; ks < N; ++ks) b[ks] = *(const u32x4*)(ptr + 32 * ks);
}
__device__ __forceinline__ float rsq(float x) { return __builtin_amdgcn_rsqf(x); }


namespace pg8 {
constexpr int BM = 256, BK = 64, HALF = 128, HTB = HALF * BK * 2, STAGE_BYTES = 8 * HTB, NXCD = 8, WGM = 8;
__host__ __device__ __forceinline__ int lds_byte(int r, int c) { const int st = (r >> 4) * 2 + (c >> 5), rr = r & 15, cc = c & 31, ob = rr * 64 + cc * 2; return st * 1024 + (ob ^ (((ob >> 9) & 1) << 5)); }
__host__ __device__ __forceinline__ void stage_rc(int b, int& R, int& C) { const int st = b / 1024, sb = b % 1024, swz = sb ^ (((sb >> 9) & 1) << 5); R = (st >> 1) * 16 + swz / 64; C = (st & 1) * 32 + (swz % 64) / 2; }
__host__ __device__ __forceinline__ int perm32(int rho) { const int n = rho >> 4, i = rho & 15; return 8 * (i >> 2) + 4 * n + (i & 3); }
struct Unit { int pm, pn; };
struct Gemm { const bf16_t* A; const bf16_t* Bt; int M, N, K; };
struct StaticOrder {
    int nM, nN, nwg, G, c;
    __host__ __device__ void init(int M, int N, int G_, int c_) { nM = M / BM; nN = N / BM; nwg = nM * nN; G = G_; c = c_; }
    __host__ __device__ bool next(int i, Unit& u) const {
        const long L = (long)i * G + c; if (L >= nwg) return false;
        int wgid = (int)L; { const int q = nwg / NXCD, r = nwg % NXCD, xcd = wgid % NXCD, off = wgid / NXCD; wgid = (xcd < r ? xcd * (q + 1) : r * (q + 1) + (xcd - r) * q) + off; }
        const int nig = WGM * nN, gid = wgid / nig, fm = gid * WGM, gsz = (nM - fm) < WGM ? (nM - fm) : WGM;
        u.pm = fm + ((wgid % nig) % gsz); u.pn = (wgid % nig) / gsz; return true;
    }
};

struct OrderA {
    StaticOrder base; int c, G;
    __host__ __device__ void init(int M, int G_, int c_) { base.init(M, 6 * BM, G_, c_); c = c_; G = G_; }
    __host__ __device__ bool next(int i, Unit& u) const {
        const int nr = (base.nwg + G - 1) / G;
        if (i < nr) return base.next(i, u);
        const int j = (i - nr) * G + c; if (j >= base.nM) return false;
        u.pm = j; u.pn = 6; return true;
    }
};

__device__ __forceinline__ float row_rs(const float* ssq, int row) {
    const f32x4* p = (const f32x4*)(ssq + (size_t)row * 16);
    const f32x4 a = p[0], b = p[1], c = p[2], d = p[3];
    const float s = ((a[0] + a[1]) + (a[2] + a[3])) + ((b[0] + b[1]) + (b[2] + b[3])) + ((c[0] + c[1]) + (c[2] + c[3])) + ((d[0] + d[1]) + (d[2] + d[3]));
    return 1.0f / sqrtf(s * (1.0f / DM) + EPS);
}
template <int ACT  , bool HALF_LAST_ = false> struct EpiScaleBf16 {
    static constexpr bool PERM = true, HALF_LAST = HALF_LAST_;
    bf16_t* O; int ldc; const LAS float* rstab;
    __device__ __forceinline__ void operator()(const f32x4 (&acc)[2][2][4][2], const Unit& u, int ui, int wr, int wc, int fr, int fq) const {
        const int lrow0 = wr * 64 + fr, row0 = u.pm * BM + lrow0, col0 = u.pn * BM + wc * 32 + 8 * fq;
        float rsv[2][4];
#pragma unroll
        for (int ai = 0; ai < 2; ++ai)
#pragma unroll
            for (int m = 0; m < 4; ++m) rsv[ai][m] = rstab[ui * 256 + lrow0 + ai * HALF + m * 16];
#pragma unroll
        for (int ai = 0; ai < 2; ++ai)
#pragma unroll
            for (int m = 0; m < 4; ++m) {
                const int row = row0 + ai * HALF + m * 16; const float rs = rsv[ai][m];
                bf16_t* rowp = O + (size_t)row * ldc + col0;
#pragma unroll
                for (int bj = 0; bj < 2; ++bj) {
                    if (HALF_LAST && bj == 1 && u.pn == 6) continue;
                    f32x4 v0 = acc[ai][bj][m][0] * rs, v1 = acc[ai][bj][m][1] * rs;
                    if (ACT == 1) {
#pragma unroll
                        for (int j = 0; j < 4; ++j) { const float a = fmaxf(v0[j], 0.f), b = fmaxf(v1[j], 0.f); v0[j] = a * a; v1[j] = b * b; }
                    }
                    u32x4 w; w.x = pk2(v0[0], v0[1]); w.y = pk2(v0[2], v0[3]); w.z = pk2(v1[0], v1[1]); w.w = pk2(v1[2], v1[3]);
                    *(u32x4*)(rowp + bj * HALF) = w;
                }
            }
    }
};
template <class Sched>
__device__ __forceinline__ void build_rs_table(LAS float* rstab, const Sched& S, const float* ssq) {
    int tid = threadIdx.x; asm volatile("" : "+v"(tid));
    Unit u;
#pragma unroll 1
    for (int i0 = 0; i0 < 16; i0 += 8) {
        f32x4 pv[4][4]; bool ok[4];
#pragma unroll
        for (int q = 0; q < 4; ++q) { const int i = i0 + 2 * q + (tid >> 8); ok[q] = S.next(i, u);
            const f32x4* pp = (const f32x4*)(ssq + (size_t)((ok[q] ? u.pm : 0) * BM + (tid & 255)) * 16);
#pragma unroll
            for (int j = 0; j < 4; ++j) pv[q][j] = pp[j]; }
#pragma unroll
        for (int q = 0; q < 4; ++q) { const int i = i0 + 2 * q + (tid >> 8);
            const f32x4 a = pv[q][0], b = pv[q][1], c = pv[q][2], d = pv[q][3];
            const float sm = ((a[0] + a[1]) + (a[2] + a[3])) + ((b[0] + b[1]) + (b[2] + b[3])) + ((c[0] + c[1]) + (c[2] + c[3])) + ((d[0] + d[1]) + (d[2] + d[3]));
            if (ok[q]) rstab[i * 256 + (tid & 255)] = 1.0f / sqrtf(sm * (1.0f / DM) + EPS); }
    }
    __syncthreads();
}
struct EpiResidual {
    static constexpr bool PERM = true, HALF_LAST = false;
    bf16_t* hb; float* ssq;
    __device__ __forceinline__ void operator()(const f32x4 (&acc)[2][2][4][2], const Unit& u, int  , int wr, int wc, int fr, int fq) const {
        const int row0 = u.pm * BM + wr * 64 + fr, col0 = u.pn * BM + wc * 32 + 8 * fq;
        u32x4 rv[2][2];
#pragma unroll
        for (int bj = 0; bj < 2; ++bj) rv[0][bj] = *(const u32x4*)(hb + (size_t)row0 * DM + col0 + bj * HALF);
#pragma unroll
        for (int g = 0; g < 8; ++g) {
            const int ai = g >> 2, m = g & 3;
            const int row = row0 + ai * HALF + m * 16; const size_t off = (size_t)row * DM + col0; float s = 0.f;
            if (g < 7) { const int g1 = g + 1; const size_t off1 = (size_t)(row0 + (g1 >> 2) * HALF + (g1 & 3) * 16) * DM + col0;
#pragma unroll
                for (int bj = 0; bj < 2; ++bj) rv[g1 & 1][bj] = *(const u32x4*)(hb + off1 + bj * HALF); }
#pragma unroll
            for (int bj = 0; bj < 2; ++bj) {
                const u32x4 r = rv[g & 1][bj]; const f32x4 a0 = acc[ai][bj][m][0], a1 = acc[ai][bj][m][1];
                u32x4 o; o.x = pk2(bf_lo(r.x) + a0[0], bf_hi(r.x) + a0[1]); o.y = pk2(bf_lo(r.y) + a0[2], bf_hi(r.y) + a0[3]);
                o.z = pk2(bf_lo(r.z) + a1[0], bf_hi(r.z) + a1[1]); o.w = pk2(bf_lo(r.w) + a1[2], bf_hi(r.w) + a1[3]);
                *(u32x4*)(hb + off + bj * HALF) = o;
#pragma unroll
                for (int e = 0; e < 4; ++e) { const float x0 = bf_lo(o[e]), x1 = bf_hi(o[e]); s += x0 * x0 + x1 * x1; }
            }
            s += __shfl_xor(s, 16); s += __shfl_xor(s, 32);
            if (fq == 0) ssq[(size_t)row * 16 + u.pn * 4 + wc] = s;
        }
    }
};

template <class Epi, class Sched>
__device__ __forceinline__ void gemm_phase(LAS unsigned char* lds, const Gemm g, const Sched& S, const Epi& E) {
    int tid = threadIdx.x; asm volatile("" : "+v"(tid));
    const int wid = __builtin_amdgcn_readfirstlane(tid >> 6), lane = tid & 63, wr = wid >> 2, wc = wid & 3, fr = lane & 15, fq = lane >> 4;
    const int K = g.K, nt = K / BK;
    unsigned voffA[2], voffB[2];
#pragma unroll
    for (int i = 0; i < 2; ++i) { int R, C; stage_rc(tid * 16 + i * 8192, R, C); const int Rb = Epi::PERM ? ((R & ~31) + perm32(R & 31)) : R;
        voffA[i] = (unsigned)(R * K + C) * 2u; voffB[i] = (unsigned)(Rb * K + C) * 2u; }
    const size_t kstep = (size_t)(BK * 2);
    const size_t hstep = (size_t)HALF * K * 2;
    const size_t tstep = 2 * hstep;
    const unsigned ldsw = (unsigned)wid * 1024u;
    const int aoff = lds_byte(wr * 64 + fr, fq * 8), boff = lds_byte(wc * 32 + fr, fq * 8);
#define PG8_SA(b, h) (((b) * 2 + (h)) * HTB)
#define PG8_SB(b, h) ((4 + (b) * 2 + (h)) * HTB)
#define PG8_STAGE(bufoff, gbase, voff) do { _Pragma("unroll") for (int _i = 0; _i < 2; ++_i) \
        __builtin_amdgcn_global_load_lds((const unsigned*)((const char*)(gbase) + (voff)[_i]), (LAS unsigned*)(lds + (bufoff) + ldsw + _i * 8192), 16, 0, 0); } while (0)
#define PG8_LDA(dst, b, h) do { _Pragma("unroll") for (int m = 0; m < 4; ++m) _Pragma("unroll") for (int k = 0; k < 2; ++k) dst[m][k] = *(const LAS bf16x8*)(lds + PG8_SA(b, h) + aoff + m * 2048 + k * 1024); } while (0)
#define PG8_LDB(dst, b, h) do { _Pragma("unroll") for (int n = 0; n < 2; ++n) _Pragma("unroll") for (int k = 0; k < 2; ++k) dst[n][k] = *(const LAS bf16x8*)(lds + PG8_SB(b, h) + boff + n * 2048 + k * 1024); } while (0)
#define PG8_MMA(ai, bj, At, Bt) do { __builtin_amdgcn_s_setprio(1); _Pragma("unroll") for (int m = 0; m < 4; ++m) _Pragma("unroll") for (int n = 0; n < 2; ++n) _Pragma("unroll") for (int k = 0; k < 2; ++k) \
        acc[ai][bj][m][n] = __builtin_amdgcn_mfma_f32_16x16x32_bf16(Bt[n][k], At[m][k], acc[ai][bj][m][n], 0, 0, 0); __builtin_amdgcn_s_setprio(0); } while (0)
#define PG8_WAIT_V(n) asm volatile("s_waitcnt vmcnt(" #n ")" ::: "memory")
#define PG8_WAIT_L(n) asm volatile("s_waitcnt lgkmcnt(" #n ")" ::: "memory")
#define PG8_BAR __builtin_amdgcn_s_barrier()
#define PG8_SCHED __builtin_amdgcn_sched_barrier(0)
#define PG8_IFFULL(x) do { if constexpr (Epi::HALF_LAST) { if (!halfu) { x; } } else { x; } } while (0)
    Unit cur, nxt; int ui = 0;
    if (!S.next(0, cur)) return;
    f32x4 acc[2][2][4][2];
#pragma unroll
    for (int a = 0; a < 2; ++a)
#pragma unroll
        for (int b = 0; b < 2; ++b)
#pragma unroll
            for (int m = 0; m < 4; ++m)
#pragma unroll
                for (int n = 0; n < 2; ++n) acc[a][b][m][n] = (f32x4){0.f, 0.f, 0.f, 0.f};
    bf16x8 At[4][2], B0[2][2], B1[2][2];
    const char* cA = (const char*)g.A + (size_t)cur.pm * tstep; const char* cB = (const char*)g.Bt + (size_t)cur.pn * tstep;
    PG8_STAGE(PG8_SB(0, 0), cB, voffB); PG8_STAGE(PG8_SA(0, 0), cA, voffA); PG8_STAGE(PG8_SB(0, 1), cB + hstep, voffB); PG8_STAGE(PG8_SA(0, 1), cA + hstep, voffA);
    if (wr == 1) PG8_BAR;
    PG8_WAIT_V(4); PG8_BAR;
    PG8_STAGE(PG8_SB(1, 0), cB + kstep, voffB); PG8_STAGE(PG8_SA(1, 0), cA + kstep, voffA); PG8_STAGE(PG8_SB(1, 1), cB + hstep + kstep, voffB);
    PG8_WAIT_V(6); PG8_BAR;
    for (;;) {
        const bool has_next = S.next(ui + 1, nxt);
        const bool halfu = Epi::HALF_LAST && cur.pn == 6; (void)halfu;
        const char* nA = has_next ? (const char*)g.A + (size_t)nxt.pm * tstep : cA; const char* nB = has_next ? (const char*)g.Bt + (size_t)nxt.pn * tstep : cB;
        for (int t = 0; t < nt; t += 2) {
            const bool last = (t == nt - 2);
            const char* a1 = cA + (size_t)(t + 1) * kstep;
            const char* a2 = last ? nA : cA + (size_t)(t + 2) * kstep; const char* b2 = last ? nB : cB + (size_t)(t + 2) * kstep;
            const char* a3 = a2 + kstep; const char* b3 = b2 + kstep;
            PG8_LDB(B0, 0, 0); PG8_SCHED; PG8_LDA(At, 0, 0); PG8_STAGE(PG8_SA(1, 1), a1 + hstep, voffA);
            PG8_WAIT_L(8); PG8_BAR; PG8_WAIT_L(0); PG8_MMA(0, 0, At, B0); PG8_BAR; PG8_SCHED;
            PG8_IFFULL(PG8_LDB(B1, 0, 1)); PG8_STAGE(PG8_SB(0, 0), b2, voffB);
            PG8_BAR; PG8_WAIT_L(0); PG8_IFFULL(PG8_MMA(0, 1, At, B1)); PG8_BAR;
            PG8_LDA(At, 0, 1); PG8_STAGE(PG8_SA(0, 0), a2, voffA);
            PG8_BAR; PG8_WAIT_L(0); PG8_MMA(1, 0, At, B0); PG8_BAR; PG8_SCHED;
            PG8_STAGE(PG8_SB(0, 1), b2 + hstep, voffB);
            PG8_WAIT_V(6); PG8_BAR; PG8_IFFULL(PG8_MMA(1, 1, At, B1)); PG8_BAR;
            PG8_LDB(B0, 1, 0); PG8_SCHED; PG8_LDA(At, 1, 0); PG8_STAGE(PG8_SA(0, 1), a2 + hstep, voffA);
            PG8_WAIT_L(8); PG8_BAR; PG8_WAIT_L(0); PG8_MMA(0, 0, At, B0); PG8_BAR; PG8_SCHED;
            PG8_IFFULL(PG8_LDB(B1, 1, 1)); PG8_STAGE(PG8_SB(1, 0), b3, voffB);
            PG8_BAR; PG8_WAIT_L(0); PG8_IFFULL(PG8_MMA(0, 1, At, B1)); PG8_BAR;
            PG8_LDA(At, 1, 1); PG8_STAGE(PG8_SA(1, 0), a3, voffA);
            PG8_BAR; PG8_WAIT_L(0); PG8_MMA(1, 0, At, B0); PG8_BAR; PG8_SCHED;
            PG8_STAGE(PG8_SB(1, 1), b3 + hstep, voffB);
            PG8_WAIT_V(6); PG8_BAR; PG8_IFFULL(PG8_MMA(1, 1, At, B1)); PG8_BAR;
        }
        E(acc, cur, ui, wr, wc, fr, fq);
        if (!has_next) break;
#pragma unroll
        for (int a = 0; a < 2; ++a)
#pragma unroll
            for (int b = 0; b < 2; ++b)
#pragma unroll
                for (int m = 0; m < 4; ++m)
#pragma unroll
                    for (int n = 0; n < 2; ++n) acc[a][b][m][n] = (f32x4){0.f, 0.f, 0.f, 0.f};
        cur = nxt; cA = nA; cB = nB; ++ui;
    }
    PG8_WAIT_V(0);
    if (wr == 0) PG8_BAR;
    PG8_BAR;
#undef PG8_SA
#undef PG8_SB
#undef PG8_STAGE
#undef PG8_LDA
#undef PG8_LDB
#undef PG8_MMA
#undef PG8_WAIT_V
#undef PG8_WAIT_L
#undef PG8_BAR
#undef PG8_SCHED
#undef PG8_IFFULL
}
}

__device__ __forceinline__ void pinf8(float (&v)[32], int o) {
    asm volatile("" : "+v"(v[o]), "+v"(v[o + 1]), "+v"(v[o + 2]), "+v"(v[o + 3]), "+v"(v[o + 4]), "+v"(v[o + 5]), "+v"(v[o + 6]), "+v"(v[o + 7]));
}
__device__ __forceinline__ void transpose_item(const float* W, int N, const float* kscale, const float* nscale, bf16_t* WT, int ldk, LAS float* scr, int item, int lane) {
    const int nblk = N / 32, kb = item / nblk, nb = item % nblk, k0 = 64 * kb, n0 = 32 * nb;
    const int c = lane & 7;
    float v[32];
    const float* src = W + (size_t)(k0 + (lane >> 5)) * N + n0 + (lane & 31);
#pragma unroll
    for (int i = 0; i < 32; ++i) v[i] = src[(size_t)(2 * i) * N];
    f32x4 ks0 = (f32x4){1.f, 1.f, 1.f, 1.f}, ks1 = ks0;
    if (kscale) { ks0 = *(const f32x4*)(kscale + k0 + 8 * c); ks1 = *(const f32x4*)(kscale + k0 + 8 * c + 4); }
    float nsv[4];
#pragma unroll
    for (int j = 0; j < 4; ++j) nsv[j] = nscale ? nscale[n0 + (lane >> 3) + 8 * j] : 1.0f;
    pinf8(v, 0); pinf8(v, 8); pinf8(v, 16); pinf8(v, 24);
#pragma unroll
    for (int i = 0; i < 32; ++i) scr[(2 * i + (lane >> 5)) * 33 + (lane & 31)] = v[i];
    asm volatile("s_waitcnt lgkmcnt(0)" ::: "memory");
#pragma unroll
    for (int j = 0; j < 4; ++j) { const int n = (lane >> 3) + 8 * j; const LAS float* s = scr + (8 * c) * 33 + n; const float ns = nsv[j];
        u32x4 o; o.x = pk2(s[0 * 33] * ks0[0] * ns, s[1 * 33] * ks0[1] * ns); o.y = pk2(s[2 * 33] * ks0[2] * ns, s[3 * 33] * ks0[3] * ns);
        o.z = pk2(s[4 * 33] * ks1[0] * ns, s[5 * 33] * ks1[1] * ns); o.w = pk2(s[6 * 33] * ks1[2] * ns, s[7 * 33] * ks1[3] * ns);
        *(u32x4*)(WT + (size_t)(n0 + n) * ldk + k0 + 8 * c) = o; }
    asm volatile("s_waitcnt lgkmcnt(0)" ::: "memory");
}

__device__ __forceinline__ void phase_prologue(KP p, LAS unsigned char* lds) {
    int tid = threadIdx.x; asm volatile("" : "+v"(tid));
    const int lane = tid & 63, wave = tid >> 6;
    const int gw = blockIdx.x * 8 + wave, NGW = gridDim.x * 8;
    LAS float* scr = (LAS float*)(lds + wave * 8448);
    unsigned char* ws = p->ws;
    constexpr int I_IN = 16 * 51, I_OUT = 16 * 32, I_FF1 = 16 * 128, I_FF2 = 64 * 32, I_PW = 4 * 8, I_UQ = 3 * 12, I_UKV = 2 * 16, I_POOL = 4 * 2;
    constexpr int I_LAYER = I_IN + I_OUT + I_FF1 + I_FF2 + I_PW + I_UQ + I_UKV + I_POOL;
    for (int it = gw; it < DEPTH * I_LAYER; it += NGW) {
        const int l = it / I_LAYER; int r = it % I_LAYER;
        if (r < I_IN) { transpose_item(p->w_in + (size_t)l * DM * DIN, DIN, p->mix_norm_g + l * DM, nullptr, (bf16_t*)(ws + OFF_WIN + l * SZ_WIN), DM, scr, r, lane); continue; } r -= I_IN;
        if (r < I_OUT) { transpose_item(p->w_out + (size_t)l * DM * DM, DM, p->group_norm_g + l * DM, nullptr, (bf16_t*)(ws + OFF_WOUT + l * SZ_WOUT), DM, scr, r, lane); continue; } r -= I_OUT;
        if (r < I_FF1) { transpose_item(p->w_ff1 + (size_t)l * DM * DFF, DFF, p->ffn_norm_g + l * DM, nullptr, (bf16_t*)(ws + OFF_W1 + l * SZ_W1), DM, scr, r, lane); continue; } r -= I_FF1;
        if (r < I_FF2) { transpose_item(p->w_ff2 + (size_t)l * DFF * DM, DM, nullptr, nullptr, (bf16_t*)(ws + OFF_W2 + l * SZ_W2), DFF, scr, r, lane); continue; } r -= I_FF2;
        if (r < I_PW) { transpose_item(p->conv_pw_w + (size_t)l * 256 * 256, 256, nullptr, nullptr, (bf16_t*)(ws + OFF_PW + l * SZ_PW), 256, scr, r, lane); continue; } r -= I_PW;
        if (r < I_UQ) { transpose_item(p->mla_w_uq + (size_t)l * 192 * 384, 384, p->mla_q_norm_g + l * 192, nullptr, (bf16_t*)(ws + OFF_UQ + l * SZ_UQ), 192, scr, r, lane); continue; } r -= I_UQ;
        if (r < I_UKV) { transpose_item(p->mla_w_ukv + (size_t)l * 128 * 512, 512, p->mla_kv_norm_g + l * 128, nullptr, (bf16_t*)(ws + OFF_UKV + l * SZ_UKV), 128, scr, r, lane); continue; } r -= I_UKV;
        { const int g = r >> 1, sub = r & 1;
          transpose_item(p->pool_w + (size_t)(l * 4 + g) * 64 * 64, 64, nullptr, p->pool_scale + l * 256 + g * 64, (bf16_t*)(ws + OFF_POOL + l * SZ_POOL) + g * 64 * 64, 64, scr, sub, lane); }
    }
    const int gt = blockIdx.x * 512 + tid, NGT = gridDim.x * 512;
    for (int i = gt; i < DEPTH * 160 * (DM / 8); i += NGT) { const int l = i / (160 * 128), r = i % (160 * 128);
        *(u32x4*)((bf16_t*)(ws + OFF_WIN + l * SZ_WIN) + (size_t)(DIN + r / 128) * DM + (r % 128) * 8) = (u32x4){0u, 0u, 0u, 0u}; }
    for (int i = gt; i < DEPTH * 4 * 128 * 128 / 2; i += NGT) { const int e = 2 * i, jj = e & 127, ii = (e >> 7) & 127; const f32x2 v = *(const f32x2*)(p->gmlp_ws + e);
        *(unsigned*)((bf16_t*)(ws + OFF_GWS) + e) = pk2(jj <= ii ? v[0] : 0.f, (jj + 1) <= ii ? v[1] : 0.f); }
    for (int i = gt; i < M_TOK * 16; i += NGT) { const int row = i >> 4, k = i & 15; const float ang = (float)p->positions[row] * INV_FREQ[k];
        const double a = (double)ang; const double n = rint(a * 0.15915494309189535); const float rr = (float)(a - n * 6.283185307179586);
        float* rt = (float*)(ws + OFF_ROPE) + (size_t)row * 32; rt[k] = cosf(rr); rt[16 + k] = sinf(rr); }
    for (int r4 = gw; r4 < M_TOK / 4; r4 += NGW) {
        u32x4 xv[16];
#pragma unroll
        for (int q = 0; q < 4; ++q)
#pragma unroll
            for (int j = 0; j < 4; ++j) xv[4 * q + j] = *((const u32x4*)(p->x + (size_t)(4 * r4 + q) * DM) + lane + 64 * j);
        pin(xv);
        float sv[4];
#pragma unroll
        for (int q = 0; q < 4; ++q) {
            u32x2* hr = (u32x2*)((bf16_t*)(ws + OFF_HB) + (size_t)(4 * r4 + q) * DM) + lane; float s = 0.f;
#pragma unroll
            for (int j = 0; j < 4; ++j) { const f32x4 v = __builtin_bit_cast(f32x4, xv[4 * q + j]); s += (v[0] * v[0] + v[1] * v[1]) + (v[2] * v[2] + v[3] * v[3]); u32x2 w2; w2.x = pk2(v[0], v[1]); w2.y = pk2(v[2], v[3]); hr[64 * j] = w2; }
            sv[q] = s;
        }
#pragma unroll
        for (int o = 1; o < 64; o <<= 1)
#pragma unroll
            for (int q = 0; q < 4; ++q) sv[q] += __shfl_xor(sv[q], o);
        const float mine = (lane >> 4) == 0 ? sv[0] : ((lane >> 4) == 1 ? sv[1] : ((lane >> 4) == 2 ? sv[2] : sv[3]));
        ((float*)(ws + OFF_SSQA))[(size_t)(4 * r4) * 16 + lane] = (lane & 15) == 0 ? mine : 0.f;
    }
}

constexpr int R1_BYTES = 88064, R2_OFF = R1_BYTES, R2_BYTES = 67584, R3_OFF = R2_OFF + R2_BYTES;
constexpr int YLD = 264, CQLD = 200, CKLD = 136, VLD = 136, CK_OFF = 128 * CQLD * 2, RS_OFF = CK_OFF + 128 * CKLD * 2;
static_assert(RS_OFF + 1024 <= R1_BYTES && R3_OFF + 8192 <= LDS_BYTES, "mixer LDS map");

template <int NKS, int NNT>
__device__ __forceinline__ void wgemm(f32x4 (&acc)[8][NNT], const LAS bf16_t* A, const int lda, const bf16_t* Bp, const int ldb) {
    u32x4 bf[NNT][NKS];
#pragma unroll
    for (int nt = 0; nt < NNT; ++nt) ldfr(bf[nt], Bp + (size_t)(16 * nt) * ldb);
#pragma unroll
    for (int nt = 0; nt < NNT; ++nt) pin(bf[nt]);
#pragma unroll
    for (int mt = 0; mt < 8; ++mt) {
        bf16x8 af[NKS];
#pragma unroll
        for (int ks = 0; ks < NKS; ++ks) af[ks] = *(const LAS bf16x8*)(A + (16 * mt) * lda + 32 * ks);
#pragma unroll
        for (int nt = 0; nt < NNT; ++nt) { f32x4 a = (f32x4){0.f, 0.f, 0.f, 0.f};
#pragma unroll
            for (int ks = 0; ks < NKS; ++ks) a = mfma16(as_bf16x8(bf[nt][ks]), af[ks], a);
            acc[mt][nt] = a; }
    }
}
template <int NNT>
__device__ __forceinline__ void part_sumsq(const f32x4 (&acc)[8][NNT], LAS float* part, int w, int fr, int fq) {
#pragma unroll
    for (int mt = 0; mt < 8; ++mt) { float s = 0.f;
#pragma unroll
        for (int nt = 0; nt < NNT; ++nt) s += (acc[mt][nt][0] * acc[mt][nt][0] + acc[mt][nt][1] * acc[mt][nt][1]) + (acc[mt][nt][2] * acc[mt][nt][2] + acc[mt][nt][3] * acc[mt][nt][3]);
        s += __shfl_xor(s, 16); s += __shfl_xor(s, 32);
        if (fq == 0) part[(16 * mt + fr) * 8 + w] = s; }
}
template <int NNT>
__device__ __forceinline__ void norm_store(const f32x4 (&acc)[8][NNT], const LAS float* part, bf16_t* dst, int fr) {
#pragma unroll
    for (int mt = 0; mt < 8; ++mt) {
        const LAS f32x4* pp = (const LAS f32x4*)(part + (16 * mt + fr) * 8); const f32x4 a = pp[0], b = pp[1];
        const float rs = rsq((((a[0] + a[1]) + (a[2] + a[3])) + ((b[0] + b[1]) + (b[2] + b[3]))) * (1.0f / 256.0f) + EPS);
#pragma unroll
        for (int nt = 0; nt < NNT; ++nt) { u32x2 o; o.x = pk2(acc[mt][nt][0] * rs, acc[mt][nt][1] * rs); o.y = pk2(acc[mt][nt][2] * rs, acc[mt][nt][3] * rs);
            *(u32x2*)(dst + (size_t)(16 * mt) * DM + 16 * nt) = o; }
    }
}

__device__ __forceinline__ void mixer_chunk(KP p, LAS unsigned char* lds, int l, int chunk) {
    int tid = threadIdx.x; asm volatile("" : "+v"(tid));
    const int lane = tid & 63, w = __builtin_amdgcn_readfirstlane(tid >> 6), fr = lane & 15, fq = lane >> 4;
    unsigned char* ws = p->ws;
    const bf16_t* zb = (const bf16_t*)(ws + OFF_ZB);
    bf16_t* mixed = (bf16_t*)(ws + OFF_MIX);
    const int c0 = chunk * 128, bidx = chunk >> 5, s0 = (chunk & 31) * 128;
    LAS bf16_t* Y = (LAS bf16_t*)lds; LAS bf16_t* CO = (LAS bf16_t*)(lds + R2_OFF); LAS bf16_t* VT = (LAS bf16_t*)lds;
    LAS bf16_t* CQ = (LAS bf16_t*)lds; LAS bf16_t* CK = (LAS bf16_t*)(lds + CK_OFF); LAS float* RSQ = (LAS float*)(lds + RS_OFF); LAS float* RSK = RSQ + 128;
    LAS bf16_t* ZP = (LAS bf16_t*)lds; LAS bf16_t* YP = (LAS bf16_t*)(lds + R2_OFF);
    LAS float* part0 = (LAS float*)(lds + R3_OFF); LAS float* part1 = part0 + 1024;
    bf16_t* mrow = mixed + (size_t)(c0 + fr) * DM + 4 * fq;

#pragma unroll 1
    for (int half = 0; half < 2; ++half) {
        u32x4 av[5], gv[5];
#pragma unroll
        for (int i = 0; i < 5; ++i) {
            const int q = tid + 512 * (5 * half + i); int r = q >> 5; r = r < 158 ? r : 157; const int cc = (q & 31) * 8;
            const int rr = (s0 - 30 + r >= 0) ? (c0 - 30 + r) : c0;
            const bf16_t* zq = zb + (size_t)rr * DIN_P + cc; av[i] = *(const u32x4*)zq; gv[i] = *(const u32x4*)(zq + ZC_G);
        }
        pin(av); pin(gv);
#pragma unroll
        for (int i = 0; i < 5; ++i) {
            const int q = tid + 512 * (5 * half + i); const int r = q >> 5, cc = (q & 31) * 8;
            u32x4 o;
#pragma unroll
            for (int e = 0; e < 4; ++e) o[e] = pk2(bf_lo(av[i][e]) * sigmoidf_(bf_lo(gv[i][e])), bf_hi(av[i][e]) * sigmoidf_(bf_hi(gv[i][e])));
            if (s0 - 30 + r < 0) o = (u32x4){0u, 0u, 0u, 0u};
            if (r < 158) *(LAS u32x4*)(Y + r * YLD + cc) = o;
        }
    }
    __syncthreads();
    {
        const int hc = w & 1, tq = w >> 1, c = 128 * hc + 2 * lane;
        const float* dw = p->conv_dw_w + (size_t)l * 31 * 256 + c;
        float w0[31], w1[31];
#pragma unroll
        for (int j = 0; j < 31; ++j) { const f32x2 ww = *(const f32x2*)(dw + j * 256); w0[j] = ww[0]; w1[j] = ww[1]; }
        const f32x2 bb = *(const f32x2*)(p->conv_dw_b + l * 256 + c);
#pragma unroll 1
        for (int blk = 0; blk < 4; ++blk) {
            const int t0 = 32 * tq + 8 * blk;
            float a0[8], a1[8];
#pragma unroll
            for (int o = 0; o < 8; ++o) { a0[o] = bb[0]; a1[o] = bb[1]; }
#pragma unroll
            for (int r = 0; r < 38; ++r) {
                const unsigned yv = *(const LAS unsigned*)(Y + (t0 + r) * YLD + c); const float y0 = bf_lo(yv), y1 = bf_hi(yv);
#pragma unroll
                for (int o = 0; o < 8; ++o) { const int j = r - o; if (j >= 0 && j <= 30) { a0[o] += w0[j] * y0; a1[o] += w1[j] * y1; } }
            }
#pragma unroll
            for (int o = 0; o < 8; ++o) *(LAS unsigned*)(CO + (t0 + o) * YLD + c) = pk2(a0[o], a1[o]);
        }
    }
    __syncthreads();
    u32x4 sq[6], sk[4];
#pragma unroll
    for (int i = 0; i < 6; ++i) { const int q = tid + 512 * i, r = q / 24, pc = q % 24; sq[i] = *(const u32x4*)(zb + (size_t)(c0 + r) * DIN_P + ZC_CQ + 8 * pc); }
#pragma unroll
    for (int i = 0; i < 4; ++i) { const int q = tid + 512 * i, r = q >> 4, pc = q & 15; sk[i] = *(const u32x4*)(zb + (size_t)(c0 + r) * DIN_P + ZC_CKV + 8 * pc); }
    {
        const f32x4 lg = *(const f32x4*)(p->conv_ln_g + l * 256 + 4 * lane), lb = *(const f32x4*)(p->conv_ln_b + l * 256 + 4 * lane);
#pragma unroll 1
        for (int half = 0; half < 2; ++half) {
            f32x4 x[8]; float s[8];
#pragma unroll
            for (int i = 0; i < 8; ++i) { const u32x2 v = *(const LAS u32x2*)(CO + (16 * w + 8 * half + i) * YLD + 4 * lane);
                x[i] = (f32x4){bf_lo(v.x), bf_hi(v.x), bf_lo(v.y), bf_hi(v.y)}; s[i] = (x[i][0] + x[i][1]) + (x[i][2] + x[i][3]); }
#pragma unroll
            for (int o = 1; o < 64; o <<= 1)
#pragma unroll
                for (int i = 0; i < 8; ++i) s[i] += __shfl_xor(s[i], o);
#pragma unroll
            for (int i = 0; i < 8; ++i) { x[i] = x[i] - s[i] * (1.0f / 256.0f); s[i] = (x[i][0] * x[i][0] + x[i][1] * x[i][1]) + (x[i][2] * x[i][2] + x[i][3] * x[i][3]); }
#pragma unroll
            for (int o = 1; o < 64; o <<= 1)
#pragma unroll
                for (int i = 0; i < 8; ++i) s[i] += __shfl_xor(s[i], o);
#pragma unroll
            for (int i = 0; i < 8; ++i) {
                const float rstd = rsq(s[i] * (1.0f / 256.0f) + EPS);
                f32x4 y = x[i] * rstd * lg + lb;
#pragma unroll
                for (int j = 0; j < 4; ++j) y[j] = y[j] * sigmoidf_(y[j]);
                u32x2 o; o.x = pk2(y[0], y[1]); o.y = pk2(y[2], y[3]); *(LAS u32x2*)(CO + (16 * w + 8 * half + i) * YLD + 4 * lane) = o;
            }
        }
    }
    pin(sq); pin(sk);
#pragma unroll
    for (int i = 0; i < 6; ++i) { const int q = tid + 512 * i, r = q / 24, pc = q % 24; *(LAS u32x4*)(CQ + r * CQLD + 8 * pc) = sq[i]; }
#pragma unroll
    for (int i = 0; i < 4; ++i) { const int q = tid + 512 * i, r = q >> 4, pc = q & 15; *(LAS u32x4*)(CK + r * CKLD + 8 * pc) = sk[i]; }
    __syncthreads();
    f32x4 accc[8][2];
    wgemm<8, 2>(accc, CO + fr * YLD + 8 * fq, YLD, (const bf16_t*)(ws + OFF_PW + l * SZ_PW) + (size_t)(32 * w + fr) * 256 + 8 * fq, 256);
    part_sumsq<2>(accc, part0, w, fr, fq);
    {
        float ssq_ = 0.f, ssk = 0.f;
#pragma unroll
        for (int ks = 0; ks < 6; ++ks) ssq_ += sumsq8(*(const LAS u32x4*)(CQ + (16 * w + fr) * CQLD + 32 * ks + 8 * fq));
#pragma unroll
        for (int ks = 0; ks < 4; ++ks) ssk += sumsq8(*(const LAS u32x4*)(CK + (16 * w + fr) * CKLD + 32 * ks + 8 * fq));
        ssq_ += __shfl_xor(ssq_, 16); ssq_ += __shfl_xor(ssq_, 32); ssk += __shfl_xor(ssk, 16); ssk += __shfl_xor(ssk, 32);
        if (fq == 0) { RSQ[16 * w + fr] = QSCALE * rsq(ssq_ * (1.0f / 192.0f) + EPS); RSK[16 * w + fr] = rsq(ssk * (1.0f / 128.0f) + EPS); }
        const int row = c0 + 16 * w + fr, spos = s0 + 16 * w + fr;
        const bf16_t* zr = zb + (size_t)row * DIN_P; const float* rt = (const float*)(ws + OFF_ROPE) + (size_t)row * 32;
        const u32x2 r1 = *(const u32x2*)(zr + ZC_KR + 4 * fq), r2 = *(const u32x2*)(zr + ZC_KR + 16 + 4 * fq);
        const f32x4 cs = *(const f32x4*)(rt + 4 * fq), sn = *(const f32x4*)(rt + 16 + 4 * fq);
        const f32x4 k1 = (f32x4){bf_lo(r1.x), bf_hi(r1.x), bf_lo(r1.y), bf_hi(r1.y)}, k2 = (f32x4){bf_lo(r2.x), bf_hi(r2.x), bf_lo(r2.y), bf_hi(r2.y)};
        const f32x4 o1 = k1 * cs - k2 * sn, o2 = k2 * cs + k1 * sn;
        u32x2 ro1, ro2; ro1.x = pk2(o1[0], o1[1]); ro1.y = pk2(o1[2], o1[3]); ro2.x = pk2(o2[0], o2[1]); ro2.y = pk2(o2[2], o2[3]);
        bf16_t* kd = (bf16_t*)(ws + OFF_K) + ((size_t)(bidx * 4) * SEQ + spos) * 96 + 64 + 4 * fq;
#pragma unroll
        for (int h = 0; h < 4; ++h) { *(u32x2*)(kd + (size_t)h * SEQ * 96) = ro1; *(u32x2*)(kd + (size_t)h * SEQ * 96 + 16) = ro2; }
    }
    __syncthreads();
    norm_store<2>(accc, part0, mrow + 0 + 32 * w, fr);
    {
        f32x4 acc[8][3];
        wgemm<6, 3>(acc, CQ + fr * CQLD + 8 * fq, CQLD, (const bf16_t*)(ws + OFF_UQ + l * SZ_UQ) + (size_t)(48 * w + fr) * 192 + 8 * fq, 192);
        const int head = (3 * w) / 6, d0 = 16 * ((3 * w) % 6);
        u32x4 csn[16];
        if (w & 1) {
#pragma unroll
            for (int mt = 0; mt < 8; ++mt) { const float* rt = (const float*)(ws + OFF_ROPE) + (size_t)(c0 + 16 * mt + fr) * 32 + 4 * fq; csn[2 * mt] = *(const u32x4*)rt; csn[2 * mt + 1] = *(const u32x4*)(rt + 16); }
            pin(csn);
        }
#pragma unroll
        for (int mt = 0; mt < 8; ++mt) {
            const float rs = RSQ[16 * mt + fr];
            f32x4 a0 = acc[mt][0] * rs, a1 = acc[mt][1] * rs, a2 = acc[mt][2] * rs;
            if (w & 1) { const f32x4 cs = __builtin_bit_cast(f32x4, csn[2 * mt]), sn = __builtin_bit_cast(f32x4, csn[2 * mt + 1]); const f32x4 x1 = a1, x2 = a2; a1 = x1 * cs - x2 * sn; a2 = x2 * cs + x1 * sn; }
            bf16_t* qd = (bf16_t*)(ws + OFF_Q) + ((size_t)(bidx * 4 + head) * SEQ + s0 + 16 * mt + fr) * 96 + d0 + 4 * fq;
            u32x2 o; o.x = pk2(a0[0], a0[1]); o.y = pk2(a0[2], a0[3]); *(u32x2*)(qd) = o;
            o.x = pk2(a1[0], a1[1]); o.y = pk2(a1[2], a1[3]); *(u32x2*)(qd + 16) = o;
            o.x = pk2(a2[0], a2[1]); o.y = pk2(a2[2], a2[3]); *(u32x2*)(qd + 32) = o;
        }
    }
#pragma unroll 1
    for (int pz = 0; pz < 2; ++pz) {
        f32x4 acc[8][2];
        wgemm<4, 2>(acc, CK + fr * CKLD + 8 * fq, CKLD, (const bf16_t*)(ws + OFF_UKV + l * SZ_UKV) + (size_t)(64 * w + 32 * pz + fr) * 128 + 8 * fq, 128);
        const int head = w >> 1;
#pragma unroll
        for (int mt = 0; mt < 8; ++mt) {
            const float rs = RSK[16 * mt + fr]; const int spos = s0 + 16 * mt + fr;
#pragma unroll
            for (int n = 0; n < 2; ++n) {
                const f32x4 a = acc[mt][n] * rs; const unsigned p0 = pk2(a[0], a[1]), p1 = pk2(a[2], a[3]);
                if ((w & 1) == 0) { u32x2 o; o.x = p0; o.y = p1; *(u32x2*)((bf16_t*)(ws + OFF_K) + ((size_t)(bidx * 4 + head) * SEQ + spos) * 96 + 16 * (2 * pz + n) + 4 * fq) = o; }
                else { bf16_t* vv = (bf16_t*)(ws + OFF_VT) + ((size_t)(bidx * 4 + head) * 64 + 16 * (2 * pz + n) + 4 * fq) * SEQ + spos;
                    vv[0] = (bf16_t)(p0 & 0xffff); vv[SEQ] = (bf16_t)(p0 >> 16); vv[2 * SEQ] = (bf16_t)(p1 & 0xffff); vv[3 * SEQ] = (bf16_t)(p1 >> 16); }
            }
        }
    }
    __syncthreads();
    {
        u32x4 zv[9];
#pragma unroll
        for (int i = 0; i < 9; ++i) { int q = tid + 512 * i; q = q < 143 * 32 ? q : 143 * 32 - 1; const int r = q >> 5, pc = q & 31; const int rr = (s0 - 15 + r >= 0) ? (c0 - 15 + r) : c0;
            zv[i] = *(const u32x4*)(zb + (size_t)rr * DIN_P + ZC_POOL + 8 * pc); }
        { u32x4 (&z8)[8] = *(u32x4 (*)[8])&zv[0]; pin(z8); }
#pragma unroll
        for (int i = 0; i < 9; ++i) { const int q = tid + 512 * i; if (q < 143 * 32) *(LAS u32x4*)(ZP + (q >> 5) * YLD + 8 * (q & 31)) = zv[i]; }
    }
    __syncthreads();
#pragma unroll
    for (int i = 0; i < 8; ++i) {
        const int g = i & 3, W = 2 << g, idx = tid + 512 * (i >> 2), r = idx >> 3, pc = 8 * g + (idx & 7);
        const int spos = s0 + r; const int cnt = (spos + 1) < W ? (spos + 1) : W; const float inv = 1.0f / (float)cnt;
        const LAS bf16_t* zp = ZP + (r + 15) * YLD + 8 * pc;
        float sum[8];
#pragma unroll
        for (int e = 0; e < 8; ++e) sum[e] = 0.f;
        const u32x4 self = *(const LAS u32x4*)zp;
#pragma unroll
        for (int j = 0; j < W; ++j) { const u32x4 v = *(const LAS u32x4*)(zp - j * YLD); const float m = j < cnt ? 1.f : 0.f;
#pragma unroll
            for (int e = 0; e < 4; ++e) { sum[2 * e] += m * bf_lo(v[e]); sum[2 * e + 1] += m * bf_hi(v[e]); } }
        u32x4 yv;
#pragma unroll
        for (int e = 0; e < 4; ++e) yv[e] = pk2(sum[2 * e] * inv - bf_lo(self[e]), sum[2 * e + 1] * inv - bf_hi(self[e]));
        *(LAS u32x4*)(YP + r * YLD + 8 * pc) = yv;
    }
    u32x4 vv[8];
    {
        const bf16_t* vr = zb + (size_t)(c0 + 16 * w + (lane >> 2)) * DIN_P + ZC_V + 64 * (lane & 3);
#pragma unroll
        for (int i = 0; i < 8; ++i) vv[i] = *(const u32x4*)(vr + 8 * i);
    }
    __syncthreads();
    f32x4 accp[8][2];
    {
        const int g = w >> 1, t0 = 2 * (w & 1);
        wgemm<2, 2>(accp, YP + fr * YLD + 64 * g + 8 * fq, YLD, (const bf16_t*)(ws + OFF_POOL + l * SZ_POOL) + (size_t)(64 * g + 16 * t0 + fr) * 64 + 8 * fq, 64);
        part_sumsq<2>(accp, part1, w, fr, fq);
    }
    {
        pin(vv);
        const int j = 16 * w + (lane >> 2), q4 = lane & 3; float ss = 0.f;
#pragma unroll
        for (int i = 0; i < 8; ++i) ss += sumsq8(vv[i]);
        ss += __shfl_xor(ss, 1); ss += __shfl_xor(ss, 2);
        const float rs = rsq(ss * (1.0f / 256.0f) + EPS);
        const float* gg = p->gmlp_norm_g + l * 256 + 64 * q4;
#pragma unroll
        for (int i = 0; i < 8; ++i) {
            const f32x4 g0 = *(const f32x4*)(gg + 8 * i), g1 = *(const f32x4*)(gg + 8 * i + 4);
#pragma unroll
            for (int e = 0; e < 4; ++e) { const int d = 8 * i + 2 * e; const float ga = e < 2 ? g0[2 * e] : g1[2 * e - 4], gb = e < 2 ? g0[2 * e + 1] : g1[2 * e - 3];
                const unsigned pk = pk2(bf_lo(vv[i][e]) * rs * ga, bf_hi(vv[i][e]) * rs * gb);
                VT[(64 * q4 + d) * VLD + j] = (bf16_t)(pk & 0xffff); VT[(64 * q4 + d + 1) * VLD + j] = (bf16_t)(pk >> 16); }
        }
    }
    __syncthreads();
    norm_store<2>(accp, part1, mrow + 512 + 64 * (w >> 1) + 32 * (w & 1), fr);
    {
        const int h = w >> 1, t0 = 2 * (w & 1);
        bf16x8 vf[2][4];
#pragma unroll
        for (int n = 0; n < 2; ++n)
#pragma unroll
            for (int ks = 0; ks < 4; ++ks) vf[n][ks] = *(const LAS bf16x8*)(VT + (64 * h + 16 * (t0 + n) + fr) * VLD + 32 * ks + 8 * fq);
        const bf16_t* gwp = (const bf16_t*)(ws + OFF_GWS + l * SZ_GWS) + (size_t)(h * 128 + fr) * 128 + 8 * fq;
        u32x2 uu[16]; float bias[8];
#pragma unroll
        for (int mt = 0; mt < 8; ++mt) {
            bias[mt] = p->gmlp_bs[(l * 4 + h) * 128 + 16 * mt + fr];
#pragma unroll
            for (int n = 0; n < 2; ++n) uu[2 * mt + n] = *(const u32x2*)(zb + (size_t)(c0 + 16 * mt + fr) * DIN_P + ZC_U + 64 * h + 16 * (t0 + n) + 4 * fq);
        }
        f32x4 acc[8][2];
#pragma unroll
        for (int mp = 0; mp < 4; ++mp) {
            u32x4 wf[8];
#pragma unroll
            for (int q = 0; q < 2; ++q)
#pragma unroll
                for (int ks = 0; ks < 4; ++ks) wf[4 * q + ks] = *(const u32x4*)(gwp + (size_t)(16 * (2 * mp + q)) * 128 + 32 * (ks <= mp ? ks : 0));
            pin(wf);
#pragma unroll
            for (int q = 0; q < 2; ++q)
#pragma unroll
                for (int n = 0; n < 2; ++n) { f32x4 a = (f32x4){0.f, 0.f, 0.f, 0.f};
#pragma unroll
                    for (int ks = 0; ks < 4; ++ks) if (ks <= mp) a = mfma16(vf[n][ks], as_bf16x8(wf[4 * q + ks]), a);
                    const int mt = 2 * mp + q; const u32x2 u2 = uu[2 * mt + n]; const float bs_ = bias[mt];
                    a[0] = bf_lo(u2.x) * (a[0] + bs_); a[1] = bf_hi(u2.x) * (a[1] + bs_); a[2] = bf_lo(u2.y) * (a[2] + bs_); a[3] = bf_hi(u2.y) * (a[3] + bs_);
                    acc[mt][n] = a; }
        }
        part_sumsq<2>(acc, part0, w, fr, fq);
        __syncthreads();
        norm_store<2>(acc, part0, mrow + 768 + 64 * h + 16 * t0, fr);
    }
    __syncthreads();
}

constexpr int KLD = 104, VSLD = 136, KS_BYTES = 128 * KLD * 2, VS_BYTES = 64 * VSLD * 2, KV_BUF = KS_BYTES + VS_BYTES;

__device__ __forceinline__ void attn_block(KP p, LAS unsigned char* lds, int bh, int q0) {
    int tid = threadIdx.x; asm volatile("" : "+v"(tid));
    const int lane = tid & 63, w = __builtin_amdgcn_readfirstlane(tid >> 6), lr = lane & 31, lh = lane >> 5;
    unsigned char* ws = p->ws;
    const bf16_t* Qg = (const bf16_t*)(ws + OFF_Q) + (size_t)bh * SEQ * 96;
    const bf16_t* Kg = (const bf16_t*)(ws + OFF_K) + (size_t)bh * SEQ * 96;
    const bf16_t* Vg = (const bf16_t*)(ws + OFF_VT) + (size_t)bh * 64 * SEQ;
    const int qrow = q0 + 32 * w + lr, wave_q0 = q0 + 32 * w;
    bf16x8 qf[6];
#pragma unroll
    for (int ks = 0; ks < 6; ++ks) qf[ks] = *(const bf16x8*)(Qg + (size_t)qrow * 96 + 16 * ks + 8 * lh);
    f32x16 o0, o1;
#pragma unroll
    for (int i = 0; i < 16; ++i) { o0[i] = 0.f; o1[i] = 0.f; }
    float mrun = -1e30f, lrun = 0.f;
    const int nst = (q0 + 256) / 128;
    u32x4 rk[3], rv[2];
#pragma unroll
    for (int i = 0; i < 3; ++i) { const int q = tid + 512 * i; rk[i] = *(const u32x4*)(Kg + (size_t)(q / 12) * 96 + 8 * (q % 12)); }
#pragma unroll
    for (int i = 0; i < 2; ++i) { const int q = tid + 512 * i; rv[i] = *(const u32x4*)(Vg + (size_t)(q >> 4) * SEQ + 8 * (q & 15)); }
    for (int st = 0; st < nst; ++st) {
        LAS bf16_t* ksm0 = (LAS bf16_t*)(lds + (st & 1) * KV_BUF); LAS bf16_t* vsm0 = (LAS bf16_t*)(lds + (st & 1) * KV_BUF + KS_BYTES);
#pragma unroll
        for (int i = 0; i < 3; ++i) { const int q = tid + 512 * i; *(LAS u32x4*)(ksm0 + (q / 12) * KLD + 8 * (q % 12)) = rk[i]; }
#pragma unroll
        for (int i = 0; i < 2; ++i) { const int q = tid + 512 * i; *(LAS u32x4*)(vsm0 + (q >> 4) * VSLD + 8 * (q & 15)) = rv[i]; }
        if (st + 1 < nst) {
            const int k1 = 128 * (st + 1);
#pragma unroll
            for (int i = 0; i < 3; ++i) { const int q = tid + 512 * i; rk[i] = *(const u32x4*)(Kg + (size_t)(k1 + q / 12) * 96 + 8 * (q % 12)); }
#pragma unroll
            for (int i = 0; i < 2; ++i) { const int q = tid + 512 * i; rv[i] = *(const u32x4*)(Vg + (size_t)(q >> 4) * SEQ + k1 + 8 * (q & 15)); }
        }
        __syncthreads();
#pragma unroll
        for (int sub = 0; sub < 2; ++sub) {
        const int kt = 2 * st + sub;
        const LAS bf16_t* ksm = ksm0 + 64 * sub * KLD; const LAS bf16_t* vsm = vsm0 + 64 * sub;
        if (64 * kt <= wave_q0 + 31) {
            f32x16 s0, s1;
#pragma unroll
            for (int i = 0; i < 16; ++i) { s0[i] = 0.f; s1[i] = 0.f; }
            u32x4 ka[6], kb[6];
#pragma unroll
            for (int ks = 0; ks < 6; ++ks) { ka[ks] = *(const LAS u32x4*)(ksm + lr * KLD + 16 * ks + 8 * lh); kb[ks] = *(const LAS u32x4*)(ksm + (32 + lr) * KLD + 16 * ks + 8 * lh); }
            pin(ka); pin(kb);
#pragma unroll
            for (int ks = 0; ks < 6; ++ks) { s0 = mfma32(as_bf16x8(ka[ks]), qf[ks], s0); s1 = mfma32(as_bf16x8(kb[ks]), qf[ks], s1); }
            u32x4 va[4], vb[4];
#pragma unroll
            for (int q = 0; q < 4; ++q) { const LAS bf16_t* vp = vsm + lr * VSLD + 16 * q + 4 * lh;
                const u32x2 lo = *(const LAS u32x2*)(vp), hi = *(const LAS u32x2*)(vp + 8); va[q] = (u32x4){lo.x, lo.y, hi.x, hi.y};
                const u32x2 lo2 = *(const LAS u32x2*)(vp + 32 * VSLD), hi2 = *(const LAS u32x2*)(vp + 32 * VSLD + 8); vb[q] = (u32x4){lo2.x, lo2.y, hi2.x, hi2.y}; }
            if (64 * kt + 63 > wave_q0) {
#pragma unroll
                for (int i = 0; i < 16; ++i) { const int key = 64 * kt + (i & 3) + 8 * (i >> 2) + 4 * lh;
                    if (key > qrow) s0[i] = -1e30f; if (key + 32 > qrow) s1[i] = -1e30f; }
            }
            float mx = s0[0];
#pragma unroll
            for (int i = 1; i < 16; ++i) mx = fmaxf(mx, s0[i]);
#pragma unroll
            for (int i = 0; i < 16; ++i) mx = fmaxf(mx, s1[i]);
            mx = fmaxf(mx, __shfl_xor(mx, 32));
            if (__builtin_amdgcn_ballot_w64(mx > mrun) != 0ull) {
                const float mnew = fmaxf(mrun, mx), alpha = fast_exp2(mrun - mnew);
                lrun *= alpha; mrun = mnew; o0 = o0 * alpha; o1 = o1 * alpha;
            }
            float rsum = 0.f;
#pragma unroll
            for (int i = 0; i < 16; ++i) { s0[i] = fast_exp2(s0[i] - mrun); s1[i] = fast_exp2(s1[i] - mrun); rsum += s0[i] + s1[i]; }
            lrun += rsum;
            pin(va); pin(vb);
#pragma unroll
            for (int q = 0; q < 4; ++q) {
                u32x4 pw;
#pragma unroll
                for (int e = 0; e < 4; ++e) pw[e] = (q >> 1) == 0 ? pk2(s0[8 * (q & 1) + 2 * e], s0[8 * (q & 1) + 2 * e + 1]) : pk2(s1[8 * (q & 1) + 2 * e], s1[8 * (q & 1) + 2 * e + 1]);
                const bf16x8 pf = as_bf16x8(pw);
                o0 = mfma32(as_bf16x8(va[q]), pf, o0); o1 = mfma32(as_bf16x8(vb[q]), pf, o1);
            }
        }
        }
    }
    const float ltot = lrun + __shfl_xor(lrun, 32), inv = fast_rcp(ltot);
    o0 = o0 * inv; o1 = o1 * inv;
    float ss = 0.f;
#pragma unroll
    for (int i = 0; i < 16; ++i) ss += o0[i] * o0[i] + o1[i] * o1[i];
    ss += __shfl_xor(ss, 32);
    const int b = bh >> 2, hd = bh & 3; const size_t grow = (size_t)b * SEQ + qrow;
    if (lh == 0) ((float*)(ws + OFF_SSQM))[grow * 4 + hd] = ss;
    bf16_t* od = (bf16_t*)(ws + OFF_MIX) + grow * DM + 256 + 64 * hd + 4 * lh;
#pragma unroll
    for (int g = 0; g < 4; ++g) {
        u32x2 a, c; a.x = pk2(o0[4 * g], o0[4 * g + 1]); a.y = pk2(o0[4 * g + 2], o0[4 * g + 3]); c.x = pk2(o1[4 * g], o1[4 * g + 1]); c.y = pk2(o1[4 * g + 2], o1[4 * g + 3]);
        *(u32x2*)(od + 8 * g) = a; *(u32x2*)(od + 32 + 8 * g) = c;
    }
    __syncthreads();
}


__device__ __forceinline__ void grid_barrier(unsigned* ctr, unsigned k, unsigned nwg) {
    asm volatile("s_waitcnt vmcnt(0) lgkmcnt(0)" ::: "memory");
    __syncthreads();
    if (threadIdx.x == 0) {
        unsigned* gen = ctr + 64;
        __builtin_amdgcn_fence(__ATOMIC_RELEASE, "agent");
        asm volatile("s_waitcnt vmcnt(0)" ::: "memory");
        const unsigned old = __hip_atomic_fetch_add(ctr, 1u, __ATOMIC_RELAXED, __HIP_MEMORY_SCOPE_AGENT);
        if (old + 1u == k * nwg) __hip_atomic_store(gen, k, __ATOMIC_RELAXED, __HIP_MEMORY_SCOPE_AGENT);
        else { unsigned spins = 0; while (__hip_atomic_load(gen, __ATOMIC_RELAXED, __HIP_MEMORY_SCOPE_AGENT) < k) { __builtin_amdgcn_s_sleep(2); if (++spins > (1u << 24)) break; } }
        __builtin_amdgcn_fence(__ATOMIC_ACQUIRE, "agent");
        asm volatile("s_waitcnt vmcnt(0)" ::: "memory");
    }
    __syncthreads();
}

__global__ void __launch_bounds__(512) fwd_kernel(Params p_arg) {
    extern __shared__ __attribute__((aligned(16))) unsigned char smem[];
    LAS unsigned char* lds = (LAS unsigned char*)smem;
    cg::grid_group grid = cg::this_grid();
    const int ph_lo = p_arg.ph_lo, ph_hi = p_arg.ph_hi;
    unsigned nbar = 0;
    if (ph_lo < 0) grid.sync();
    for (int ph = ph_lo; ph < ph_hi; ++ph)
    for (int rep = 0; rep < 1 + ((DUP_MASK >> (ph == 0 ? 0 : (ph == 1 + 7 * DEPTH ? 31 : 1 + (ph - 1) % 7))) & 1); ++rep) {
        if (ph > ph_lo || rep > 0) {
            ++nbar;
            grid_barrier((unsigned*)(p_arg.ws + OFF_BAR), nbar, gridDim.x);
        }
        KP p = (KP)__builtin_amdgcn_kernarg_segment_ptr();
        asm volatile("" : "+s"(p));
        unsigned char* ws = p->ws;
        int tid = threadIdx.x; asm volatile("" : "+v"(tid));
        const int lane = tid & 63, wave = tid >> 6;
        const int gw = blockIdx.x * 8 + wave, NGW = gridDim.x * 8;
        if (ph == 0) {
#if PH_MASK & 1
 phase_prologue(p, lds);
#endif
 continue; }
        if (ph == 1 + 7 * DEPTH) {
            const float* ssq = (const float*)(ws + OFF_SSQA);
            for (int r4 = gw; r4 < M_TOK / 4; r4 += NGW) {
                u32x4 xv[8];
#pragma unroll
                for (int q = 0; q < 4; ++q)
#pragma unroll
                    for (int j = 0; j < 2; ++j) xv[2 * q + j] = *((const u32x4*)((const bf16_t*)(ws + OFF_HB) + (size_t)(4 * r4 + q) * DM) + lane + 64 * j);
                float sp = ssq[(size_t)(4 * r4) * 16 + lane];
                pin(xv);
                sp += __shfl_xor(sp, 1); sp += __shfl_xor(sp, 2); sp += __shfl_xor(sp, 4); sp += __shfl_xor(sp, 8);
                const float rsl = rsq(sp * (1.0f / DM) + EPS);
#pragma unroll
                for (int q = 0; q < 4; ++q) {
                    const float rs = __shfl(rsl, 16 * q);
#pragma unroll
                    for (int j = 0; j < 2; ++j) {
                        const f32x4* gg = (const f32x4*)(p->final_norm_g + 512 * j + 8 * lane); const f32x4 g0 = gg[0], g1 = gg[1]; const u32x4 v = xv[2 * q + j];
                        f32x4* orow = (f32x4*)(p->out + (size_t)(4 * r4 + q) * DM + 512 * j + 8 * lane);
                        orow[0] = (f32x4){bf_lo(v.x) * rs * g0[0], bf_hi(v.x) * rs * g0[1], bf_lo(v.y) * rs * g0[2], bf_hi(v.y) * rs * g0[3]};
                        orow[1] = (f32x4){bf_lo(v.z) * rs * g1[0], bf_hi(v.z) * rs * g1[1], bf_lo(v.w) * rs * g1[2], bf_hi(v.w) * rs * g1[3]};
                    }
                }
            }
            continue;
        }
        const int l = (ph - 1) / 7, sub = (ph - 1) % 7;
        pg8::StaticOrder S;
#if PH_MASK & 2
        if (sub == 0) {
            pg8::Gemm g{(const bf16_t*)(ws + OFF_HB), (const bf16_t*)(ws + OFF_WIN + l * SZ_WIN), M_TOK, DIN_P, DM};
            pg8::OrderA SA; SA.init(M_TOK, gridDim.x, blockIdx.x);
            LAS float* rstab = (LAS float*)(lds + pg8::STAGE_BYTES);
            pg8::build_rs_table(rstab, SA, (const float*)(ws + OFF_SSQA));
            pg8::EpiScaleBf16<0, true> E{(bf16_t*)(ws + OFF_ZB), DIN_P, rstab};
            pg8::gemm_phase(lds, g, SA, E);
        } else
#endif
#if PH_MASK & 4
        if (sub == 1) {
            for (int ch = blockIdx.x; ch < M_TOK / 128; ch += gridDim.x) mixer_chunk(p, lds, l, ch);
        } else
#endif
#if PH_MASK & 8
        if (sub == 2) {
            for (int it0 = blockIdx.x; it0 < 256; it0 += gridDim.x) { const int it = (it0 & 7) * 32 + (it0 >> 3);
                const int bh = it >> 3, pr = it & 7; attn_block(p, lds, bh, 256 * pr); attn_block(p, lds, bh, 256 * (15 - pr)); }
        } else
#endif
        if (sub == 3) {
            const float* sm = (const float*)(ws + OFF_SSQM); bf16_t* mixed = (bf16_t*)(ws + OFF_MIX);
            for (int r8 = gw; r8 < M_TOK / 8; r8 += NGW) {
                u32x4 mv[4]; f32x4 s4[4];
#pragma unroll
                for (int q = 0; q < 4; ++q) { const int row = 8 * r8 + 2 * q + (lane >> 5); s4[q] = *(const f32x4*)(sm + (size_t)row * 4); mv[q] = *(const u32x4*)(mixed + (size_t)row * DM + 256 + 8 * (lane & 31)); }
                pin(mv);
#pragma unroll
                for (int q = 0; q < 4; ++q) { const int row = 8 * r8 + 2 * q + (lane >> 5);
                    const float rs = rsq(((s4[q][0] + s4[q][1]) + (s4[q][2] + s4[q][3])) * (1.0f / 256.0f) + EPS); u32x4 v = mv[q];
#pragma unroll
                    for (int e = 0; e < 4; ++e) v[e] = pk2(bf_lo(v[e]) * rs, bf_hi(v[e]) * rs);
                    *(u32x4*)(mixed + (size_t)row * DM + 256 + 8 * (lane & 31)) = v; }
            }
        } else
#if PH_MASK & 16
        if (sub == 4) {
            pg8::Gemm g{(const bf16_t*)(ws + OFF_MIX), (const bf16_t*)(ws + OFF_WOUT + l * SZ_WOUT), M_TOK, DM, DM};
            S.init(M_TOK, DM, gridDim.x, blockIdx.x);
            pg8::EpiResidual E{(bf16_t*)(ws + OFF_HB), (float*)(ws + OFF_SSQF)};
            pg8::gemm_phase(lds, g, S, E);
        } else
#endif
#if PH_MASK & 32
        if (sub == 5) {
            pg8::Gemm g{(const bf16_t*)(ws + OFF_HB), (const bf16_t*)(ws + OFF_W1 + l * SZ_W1), M_TOK, DFF, DM};
            S.init(M_TOK, DFF, gridDim.x, blockIdx.x);
            LAS float* rstab = (LAS float*)(lds + pg8::STAGE_BYTES);
            pg8::build_rs_table(rstab, S, (const float*)(ws + OFF_SSQF));
            pg8::EpiScaleBf16<1> E{(bf16_t*)(ws + OFF_FB), DFF, rstab};
            pg8::gemm_phase(lds, g, S, E);
        } else
#endif
#if PH_MASK & 64
        if (sub == 6) {
            pg8::Gemm g{(const bf16_t*)(ws + OFF_FB), (const bf16_t*)(ws + OFF_W2 + l * SZ_W2), M_TOK, DM, DFF};
            S.init(M_TOK, DM, gridDim.x, blockIdx.x);
            pg8::EpiResidual E{(bf16_t*)(ws + OFF_HB), (float*)(ws + OFF_SSQA)};
            pg8::gemm_phase(lds, g, S, E);
        }
#endif
        {}
    }
}

#ifndef N_LAUNCH_MODE
#define N_LAUNCH_MODE 0
#endif

extern "C" void kernel_launch(void* const* d_in, const int* in_sizes, int n_in, void* d_out, int out_size, void* d_ws, size_t ws_size, hipStream_t stream) {
    static int grid = 0;
    if (grid == 0) {
        if (n_in != 24 || ws_size < WS_TOTAL) { fprintf(stderr, "kernel_launch: unexpected n_in %d / ws_size %zu (need %zu)\n", n_in, ws_size, (size_t)WS_TOTAL); grid = -1; return; }
        int dev = 0, cus = 0, per_cu = 0;
        hipGetDevice(&dev); hipDeviceGetAttribute(&cus, hipDeviceAttributeMultiprocessorCount, dev);
        if (hipFuncSetAttribute((const void*)fwd_kernel, hipFuncAttributeMaxDynamicSharedMemorySize, LDS_BYTES) != hipSuccess) { fprintf(stderr, "kernel_launch: hipFuncSetAttribute failed\n"); grid = -1; return; }
        if (hipOccupancyMaxActiveBlocksPerMultiprocessor(&per_cu, (const void*)fwd_kernel, 512, LDS_BYTES) != hipSuccess || per_cu < 1) { fprintf(stderr, "kernel_launch: occupancy query says %d\n", per_cu); per_cu = 1; }
        (void)hipGetLastError();
        grid = cus * 1;
    }
    if (grid < 0) return;
    Params p{};
    p.x = (const float*)d_in[0]; p.positions = (const int*)d_in[1]; p.mix_norm_g = (const float*)d_in[2]; p.w_in = (const float*)d_in[3]; p.conv_dw_w = (const float*)d_in[4];
    p.conv_dw_b = (const float*)d_in[5]; p.conv_ln_g = (const float*)d_in[6]; p.conv_ln_b = (const float*)d_in[7]; p.conv_pw_w = (const float*)d_in[8]; p.mla_q_norm_g = (const float*)d_in[9];
    p.mla_w_uq = (const float*)d_in[10]; p.mla_kv_norm_g = (const float*)d_in[11]; p.mla_w_ukv = (const float*)d_in[12]; p.pool_w = (const float*)d_in[13]; p.pool_scale = (const float*)d_in[14];
    p.gmlp_norm_g = (const float*)d_in[15]; p.gmlp_ws = (const float*)d_in[16]; p.gmlp_bs = (const float*)d_in[17]; p.group_norm_g = (const float*)d_in[18]; p.w_out = (const float*)d_in[19];
    p.ffn_norm_g = (const float*)d_in[20]; p.w_ff1 = (const float*)d_in[21]; p.w_ff2 = (const float*)d_in[22]; p.final_norm_g = (const float*)d_in[23];
    p.out = (float*)d_out; p.ws = (unsigned char*)d_ws;
    constexpr int NPH = 2 + 7 * DEPTH;
#if N_LAUNCH_MODE == 0
    p.ph_lo = 0; p.ph_hi = NPH;
    (void)hipMemsetAsync((unsigned char*)d_ws + OFF_BAR, 0, 512, stream);
    void* args[] = {&p};
    hipError_t e = hipLaunchCooperativeKernel((const void*)fwd_kernel, dim3(grid), dim3(512), args, LDS_BYTES, stream);
    if (e != hipSuccess) fprintf(stderr, "cooperative launch failed: %s (grid %d)\n", hipGetErrorString(e), grid);
#else
    for (int ph = 0; ph < NPH; ++ph) { p.ph_lo = ph; p.ph_hi = ph + 1; hipLaunchKernelGGL(fwd_kernel, dim3(grid), dim3(512), LDS_BYTES, stream, p); }
#endif
}
```

```cpp
#include <hip/hip_runtime.h>
#include <hip/hip_cooperative_groups.h>
#include <cstdio>
namespace cg = cooperative_groups;
#ifndef DUP_MASK
#define DUP_MASK 0
#endif
#ifndef MIX_MASK
#define MIX_MASK 15
#endif
#ifndef PH_MASK
#define PH_MASK 127
#endif

#define LAS __attribute__((address_space(3)))
typedef unsigned short bf16_t;
typedef short bf16x8 __attribute__((ext_vector_type(8)));
typedef short bf16x4 __attribute__((ext_vector_type(4)));
typedef float f32x4 __attribute__((ext_vector_type(4)));
typedef float f32x2 __attribute__((ext_vector_type(2)));
typedef float f32x16 __attribute__((ext_vector_type(16)));
typedef unsigned u32x4 __attribute__((ext_vector_type(4)));
typedef unsigned u32x2 __attribute__((ext_vector_type(2)));

constexpr int M_TOK = 32768, DM = 1024, SEQ = 4096, DEPTH = 4;
constexpr int DIN = 1632, DIN_P = 1792, DFF = 4096;
constexpr int ZC_G = 256, ZC_CQ = 512, ZC_CKV = 704, ZC_KR = 832, ZC_POOL = 864, ZC_U = 1120, ZC_V = 1376;
constexpr float EPS = 1e-6f;
constexpr float QSCALE = 0.14724444602590306f;

__constant__ float INV_FREQ[16] = {1.000000000e+00f, 5.623413324e-01f, 3.162277639e-01f, 1.778279394e-01f, 1.000000015e-01f, 5.623413250e-02f, 3.162277490e-02f, 1.778279431e-02f,
                                   9.999999776e-03f, 5.623413250e-03f, 3.162277630e-03f, 1.778279431e-03f, 1.000000047e-03f, 5.623413017e-04f, 3.162277571e-04f, 1.778279402e-04f};

constexpr size_t SZ_WIN = (size_t)DIN_P * DM * 2, SZ_WOUT = (size_t)DM * DM * 2, SZ_W1 = (size_t)DFF * DM * 2, SZ_W2 = SZ_W1;
constexpr size_t SZ_PW = 256 * 256 * 2, SZ_UQ = 384 * 192 * 2, SZ_UKV = 512 * 128 * 2, SZ_POOL = 4 * 64 * 64 * 2, SZ_GWS = 4 * 128 * 128 * 2;
constexpr size_t OFF_WIN = 0;
constexpr size_t OFF_WOUT = OFF_WIN + DEPTH * SZ_WIN;
constexpr size_t OFF_W1 = OFF_WOUT + DEPTH * SZ_WOUT;
constexpr size_t OFF_W2 = OFF_W1 + DEPTH * SZ_W1;
constexpr size_t OFF_PW = OFF_W2 + DEPTH * SZ_W2;
constexpr size_t OFF_UQ = OFF_PW + DEPTH * SZ_PW;
constexpr size_t OFF_UKV = OFF_UQ + DEPTH * SZ_UQ;
constexpr size_t OFF_POOL = OFF_UKV + DEPTH * SZ_UKV;
constexpr size_t OFF_GWS = OFF_POOL + DEPTH * SZ_POOL;
constexpr size_t OFF_HB = OFF_GWS + DEPTH * SZ_GWS;
constexpr size_t OFF_SSQA = OFF_HB + (size_t)M_TOK * DM * 2;
constexpr size_t OFF_SSQF = OFF_SSQA + (size_t)M_TOK * 16 * 4;
constexpr size_t OFF_SSQM = OFF_SSQF + (size_t)M_TOK * 16 * 4;
constexpr size_t OFF_ROPE = OFF_SSQM + (size_t)M_TOK * 4 * 4;
constexpr size_t OFF_UNION = OFF_ROPE + (size_t)M_TOK * 32 * 4;
constexpr size_t OFF_ZB = OFF_UNION;
constexpr size_t OFF_MIX = OFF_ZB + (size_t)M_TOK * DIN_P * 2;
constexpr size_t OFF_Q = OFF_MIX + (size_t)M_TOK * DM * 2;
constexpr size_t OFF_K = OFF_Q + (size_t)M_TOK * 384 * 2;
constexpr size_t OFF_VT = OFF_K + (size_t)M_TOK * 384 * 2;
constexpr size_t OFF_FB = OFF_UNION;
constexpr size_t WS_END = OFF_UNION + (size_t)M_TOK * DFF * 2;
constexpr size_t OFF_BAR = WS_END;
constexpr size_t WS_TOTAL = WS_END + 512;
static_assert(OFF_VT + (size_t)M_TOK * 256 * 2 <= WS_END, "union overflow");
static_assert(OFF_HB % 256 == 0 && OFF_UNION % 256 == 0, "align");

constexpr int LDS_BYTES = 163840;

struct Params;
typedef const __attribute__((address_space(4))) Params* KP;
struct Params {
    const float* x; const int* positions; const float* mix_norm_g; const float* w_in; const float* conv_dw_w; const float* conv_dw_b; const float* conv_ln_g; const float* conv_ln_b;
    const float* conv_pw_w; const float* mla_q_norm_g; const float* mla_w_uq; const float* mla_kv_norm_g; const float* mla_w_ukv; const float* pool_w; const float* pool_scale;
    const float* gmlp_norm_g; const float* gmlp_ws; const float* gmlp_bs; const float* group_norm_g; const float* w_out; const float* ffn_norm_g; const float* w_ff1; const float* w_ff2;
    const float* final_norm_g;
    float* out; unsigned char* ws;
    int ph_lo, ph_hi;
};

__device__ __forceinline__ unsigned pk2(float lo, float hi) { unsigned r; asm("v_cvt_pk_bf16_f32 %0, %1, %2" : "=v"(r) : "v"(lo), "v"(hi)); return r; }
__device__ __forceinline__ float bf_lo(unsigned w) { return __uint_as_float(w << 16); }
__device__ __forceinline__ float bf_hi(unsigned w) { return __uint_as_float(w & 0xffff0000u); }
__device__ __forceinline__ float wave_sum(float v) {
#pragma unroll
    for (int o = 1; o < 64; o <<= 1) v += __shfl_xor(v, o);
    return v;
}
__device__ __forceinline__ f32x4 mfma16(bf16x8 a, bf16x8 b, f32x4 c) { return __builtin_amdgcn_mfma_f32_16x16x32_bf16(a, b, c, 0, 0, 0); }
__device__ __forceinline__ f32x16 mfma32(bf16x8 a, bf16x8 b, f32x16 c) { return __builtin_amdgcn_mfma_f32_32x32x16_bf16(a, b, c, 0, 0, 0); }
__device__ __forceinline__ float fast_rcp(float x) { return __builtin_amdgcn_rcpf(x); }
__device__ __forceinline__ float fast_exp2(float x) { return __builtin_amdgcn_exp2f(x); }
__device__ __forceinline__ float sigmoidf_(float x) { return fast_rcp(1.0f + fast_exp2(-1.4426950408889634f * x)); }
__device__ __forceinline__ float sumsq8(u32x4 v) {
    float s = 0.f;
#pragma unroll
    for (int i = 0; i < 4; ++i) { const float a = bf_lo(v[i]), b = bf_hi(v[i]); s += a * a + b * b; }
    return s;
}
__device__ __forceinline__ bf16x8 as_bf16x8(u32x4 v) { return __builtin_bit_cast(bf16x8, v); }

template <int N> __device__ __forceinline__ void pin(u32x4 (&b)[N]) {
    static_assert(N == 2 || N == 4 || N == 5 || N == 6 || N == 8 || N == 16, "pin size");
    if constexpr (N == 2) asm volatile("" : "+v"(b[0]), "+v"(b[1]));
    else if constexpr (N == 4) asm volatile("" : "+v"(b[0]), "+v"(b[1]), "+v"(b[2]), "+v"(b[3]));
    else if constexpr (N == 5) asm volatile("" : "+v"(b[0]), "+v"(b[1]), "+v"(b[2]), "+v"(b[3]), "+v"(b[4]));
    else if constexpr (N == 6) asm volatile("" : "+v"(b[0]), "+v"(b[1]), "+v"(b[2]), "+v"(b[3]), "+v"(b[4]), "+v"(b[5]));
    else if constexpr (N == 8) asm volatile("" : "+v"(b[0]), "+v"(b[1]), "+v"(b[2]), "+v"(b[3]), "+v"(b[4]), "+v"(b[5]), "+v"(b[6]), "+v"(b[7]));
    else asm volatile("" : "+v"(b[0]), "+v"(b[1]), "+v"(b[2]), "+v"(b[3]), "+v"(b[4]), "+v"(b[5]), "+v"(b[6]), "+v"(b[7]), "+v"(b[8]), "+v"(b[9]), "+v"(b[10]), "+v"(b[11]), "+v"(b[12]), "+v"(b[13]), "+v"(b[14]), "+v"(b[15]));
}
template <int N> __device__ __forceinline__ void ldfr(u32x4 (&b)[N], const bf16_t* ptr) {
#pragma unroll
    for (int ks = 0; ks < N; ++ks) b[ks] = *(const u32x4*)(ptr + 32 * ks);
}
__device__ __forceinline__ float rsq(float x) { return __builtin_amdgcn_rsqf(x); }


namespace pg8 {
constexpr int BM = 256, BK = 64, HALF = 128, HTB = HALF * BK * 2, STAGE_BYTES = 8 * HTB, NXCD = 8, WGM = 8;
__host__ __device__ __forceinline__ int lds_byte(int r, int c) { const int st = (r >> 4) * 2 + (c >> 5), rr = r & 15, cc = c & 31, ob = rr * 64 + cc * 2; return st * 1024 + (ob ^ (((ob >> 9) & 1) << 5)); }
__host__ __device__ __forceinline__ void stage_rc(int b, int& R, int& C) { const int st = b / 1024, sb = b % 1024, swz = sb ^ (((sb >> 9) & 1) << 5); R = (st >> 1) * 16 + swz / 64; C = (st & 1) * 32 + (swz % 64) / 2; }
__host__ __device__ __forceinline__ int perm32(int rho) { const int n = rho >> 4, i = rho & 15; return 8 * (i >> 2) + 4 * n + (i & 3); }
struct Unit { int pm, pn; };
struct Gemm { const bf16_t* A; const bf16_t* Bt; int M, N, K; };
struct StaticOrder {
    int nM, nN, nwg, G, c;
    __host__ __device__ void init(int M, int N, int G_, int c_) { nM = M / BM; nN = N / BM; nwg = nM * nN; G = G_; c = c_; }
    __host__ __device__ bool next(int i, Unit& u) const {
        const long L = (long)i * G + c; if (L >= nwg) return false;
        int wgid = (int)L; { const int q = nwg / NXCD, r = nwg % NXCD, xcd = wgid % NXCD, off = wgid / NXCD; wgid = (xcd < r ? xcd * (q + 1) : r * (q + 1) + (xcd - r) * q) + off; }
        const int nig = WGM * nN, gid = wgid / nig, fm = gid * WGM, gsz = (nM - fm) < WGM ? (nM - fm) : WGM;
        u.pm = fm + ((wgid % nig) % gsz); u.pn = (wgid % nig) / gsz; return true;
    }
};

__device__ __forceinline__ float row_rs(const float* ssq, int row) {
    const f32x4* p = (const f32x4*)(ssq + (size_t)row * 16);
    const f32x4 a = p[0], b = p[1], c = p[2], d = p[3];
    const float s = ((a[0] + a[1]) + (a[2] + a[3])) + ((b[0] + b[1]) + (b[2] + b[3])) + ((c[0] + c[1]) + (c[2] + c[3])) + ((d[0] + d[1]) + (d[2] + d[3]));
    return 1.0f / sqrtf(s * (1.0f / DM) + EPS);
}
template <int ACT  > struct EpiScaleBf16 {
    static constexpr bool PERM = true;
    bf16_t* O; int ldc; const LAS float* rstab;
    __device__ __forceinline__ void operator()(const f32x4 (&acc)[2][2][4][2], const Unit& u, int ui, int wr, int wc, int fr, int fq) const {
        const int lrow0 = wr * 64 + fr, row0 = u.pm * BM + lrow0, col0 = u.pn * BM + wc * 32 + 8 * fq;
        float rsv[2][4];
#pragma unroll
        for (int ai = 0; ai < 2; ++ai)
#pragma unroll
            for (int m = 0; m < 4; ++m) rsv[ai][m] = rstab[ui * 256 + lrow0 + ai * HALF + m * 16];
#pragma unroll
        for (int ai = 0; ai < 2; ++ai)
#pragma unroll
            for (int m = 0; m < 4; ++m) {
                const int row = row0 + ai * HALF + m * 16; const float rs = rsv[ai][m];
                bf16_t* rowp = O + (size_t)row * ldc + col0;
#pragma unroll
                for (int bj = 0; bj < 2; ++bj) {
                    f32x4 v0 = acc[ai][bj][m][0] * rs, v1 = acc[ai][bj][m][1] * rs;
                    if (ACT == 1) {
#pragma unroll
                        for (int j = 0; j < 4; ++j) { const float a = fmaxf(v0[j], 0.f), b = fmaxf(v1[j], 0.f); v0[j] = a * a; v1[j] = b * b; }
                    }
                    u32x4 w; w.x = pk2(v0[0], v0[1]); w.y = pk2(v0[2], v0[3]); w.z = pk2(v1[0], v1[1]); w.w = pk2(v1[2], v1[3]);
                    *(u32x4*)(rowp + bj * HALF) = w;
                }
            }
    }
};
__device__ __forceinline__ void build_rs_table(LAS float* rstab, const StaticOrder& S, const float* ssq) {
    int tid = threadIdx.x; asm volatile("" : "+v"(tid));
    Unit u;
#pragma unroll 1
    for (int i0 = 0; i0 < 16; i0 += 8) {
        f32x4 pv[4][4]; bool ok[4];
#pragma unroll
        for (int q = 0; q < 4; ++q) { const int i = i0 + 2 * q + (tid >> 8); ok[q] = S.next(i, u);
            const f32x4* pp = (const f32x4*)(ssq + (size_t)((ok[q] ? u.pm : 0) * BM + (tid & 255)) * 16);
#pragma unroll
            for (int j = 0; j < 4; ++j) pv[q][j] = pp[j]; }
#pragma unroll
        for (int q = 0; q < 4; ++q) { const int i = i0 + 2 * q + (tid >> 8);
            const f32x4 a = pv[q][0], b = pv[q][1], c = pv[q][2], d = pv[q][3];
            const float sm = ((a[0] + a[1]) + (a[2] + a[3])) + ((b[0] + b[1]) + (b[2] + b[3])) + ((c[0] + c[1]) + (c[2] + c[3])) + ((d[0] + d[1]) + (d[2] + d[3]));
            if (ok[q]) rstab[i * 256 + (tid & 255)] = 1.0f / sqrtf(sm * (1.0f / DM) + EPS); }
    }
    __syncthreads();
}
struct EpiResidual {
    static constexpr bool PERM = true;
    bf16_t* hb; float* ssq;
    __device__ __forceinline__ void operator()(const f32x4 (&acc)[2][2][4][2], const Unit& u, int  , int wr, int wc, int fr, int fq) const {
        const int row0 = u.pm * BM + wr * 64 + fr, col0 = u.pn * BM + wc * 32 + 8 * fq;
        u32x4 rv[2][2];
#pragma unroll
        for (int bj = 0; bj < 2; ++bj) rv[0][bj] = *(const u32x4*)(hb + (size_t)row0 * DM + col0 + bj * HALF);
#pragma unroll
        for (int g = 0; g < 8; ++g) {
            const int ai = g >> 2, m = g & 3;
            const int row = row0 + ai * HALF + m * 16; const size_t off = (size_t)row * DM + col0; float s = 0.f;
            if (g < 7) { const int g1 = g + 1; const size_t off1 = (size_t)(row0 + (g1 >> 2) * HALF + (g1 & 3) * 16) * DM + col0;
#pragma unroll
                for (int bj = 0; bj < 2; ++bj) rv[g1 & 1][bj] = *(const u32x4*)(hb + off1 + bj * HALF); }
#pragma unroll
            for (int bj = 0; bj < 2; ++bj) {
                const u32x4 r = rv[g & 1][bj]; const f32x4 a0 = acc[ai][bj][m][0], a1 = acc[ai][bj][m][1];
                u32x4 o; o.x = pk2(bf_lo(r.x) + a0[0], bf_hi(r.x) + a0[1]); o.y = pk2(bf_lo(r.y) + a0[2], bf_hi(r.y) + a0[3]);
                o.z = pk2(bf_lo(r.z) + a1[0], bf_hi(r.z) + a1[1]); o.w = pk2(bf_lo(r.w) + a1[2], bf_hi(r.w) + a1[3]);
                *(u32x4*)(hb + off + bj * HALF) = o;
#pragma unroll
                for (int e = 0; e < 4; ++e) { const float x0 = bf_lo(o[e]), x1 = bf_hi(o[e]); s += x0 * x0 + x1 * x1; }
            }
            s += __shfl_xor(s, 16); s += __shfl_xor(s, 32);
            if (fq == 0) ssq[(size_t)row * 16 + u.pn * 4 + wc] = s;
        }
    }
};

template <class Epi>
__device__ __forceinline__ void gemm_phase(LAS unsigned char* lds, const Gemm g, const StaticOrder& S, const Epi& E) {
    int tid = threadIdx.x; asm volatile("" : "+v"(tid));
    const int wid = __builtin_amdgcn_readfirstlane(tid >> 6), lane = tid & 63, wr = wid >> 2, wc = wid & 3, fr = lane & 15, fq = lane >> 4;
    const int K = g.K, nt = K / BK;
    unsigned voffA[2], voffB[2];
#pragma unroll
    for (int i = 0; i < 2; ++i) { int R, C; stage_rc(tid * 16 + i * 8192, R, C); const int Rb = Epi::PERM ? ((R & ~31) + perm32(R & 31)) : R;
        voffA[i] = (unsigned)(R * K + C) * 2u; voffB[i] = (unsigned)(Rb * K + C) * 2u; }
    const size_t kstep = (size_t)(BK * 2);
    const size_t hstep = (size_t)HALF * K * 2;
    const size_t tstep = 2 * hstep;
    const unsigned ldsw = (unsigned)wid * 1024u;
    const int aoff = lds_byte(wr * 64 + fr, fq * 8), boff = lds_byte(wc * 32 + fr, fq * 8);
#define PG8_SA(b, h) (((b) * 2 + (h)) * HTB)
#define PG8_SB(b, h) ((4 + (b) * 2 + (h)) * HTB)
#define PG8_STAGE(bufoff, gbase, voff) do { _Pragma("unroll") for (int _i = 0; _i < 2; ++_i) \
        __builtin_amdgcn_global_load_lds((const unsigned*)((const char*)(gbase) + (voff)[_i]), (LAS unsigned*)(lds + (bufoff) + ldsw + _i * 8192), 16, 0, 0); } while (0)
#define PG8_LDA(dst, b, h) do { _Pragma("unroll") for (int m = 0; m < 4; ++m) _Pragma("unroll") for (int k = 0; k < 2; ++k) dst[m][k] = *(const LAS bf16x8*)(lds + PG8_SA(b, h) + aoff + m * 2048 + k * 1024); } while (0)
#define PG8_LDB(dst, b, h) do { _Pragma("unroll") for (int n = 0; n < 2; ++n) _Pragma("unroll") for (int k = 0; k < 2; ++k) dst[n][k] = *(const LAS bf16x8*)(lds + PG8_SB(b, h) + boff + n * 2048 + k * 1024); } while (0)
#define PG8_MMA(ai, bj, At, Bt) do { __builtin_amdgcn_s_setprio(1); _Pragma("unroll") for (int m = 0; m < 4; ++m) _Pragma("unroll") for (int n = 0; n < 2; ++n) _Pragma("unroll") for (int k = 0; k < 2; ++k) \
        acc[ai][bj][m][n] = __builtin_amdgcn_mfma_f32_16x16x32_bf16(Bt[n][k], At[m][k], acc[ai][bj][m][n], 0, 0, 0); __builtin_amdgcn_s_setprio(0); } while (0)
#define PG8_WAIT_V(n) asm volatile("s_waitcnt vmcnt(" #n ")" ::: "memory")
#define PG8_WAIT_L(n) asm volatile("s_waitcnt lgkmcnt(" #n ")" ::: "memory")
#define PG8_BAR __builtin_amdgcn_s_barrier()
#define PG8_SCHED __builtin_amdgcn_sched_barrier(0)
    Unit cur, nxt; int ui = 0;
    if (!S.next(0, cur)) return;
    f32x4 acc[2][2][4][2];
#pragma unroll
    for (int a = 0; a < 2; ++a)
#pragma unroll
        for (int b = 0; b < 2; ++b)
#pragma unroll
            for (int m = 0; m < 4; ++m)
#pragma unroll
                for (int n = 0; n < 2; ++n) acc[a][b][m][n] = (f32x4){0.f, 0.f, 0.f, 0.f};
    bf16x8 At[4][2], B0[2][2], B1[2][2];
    const char* cA = (const char*)g.A + (size_t)cur.pm * tstep; const char* cB = (const char*)g.Bt + (size_t)cur.pn * tstep;
    PG8_STAGE(PG8_SB(0, 0), cB, voffB); PG8_STAGE(PG8_SA(0, 0), cA, voffA); PG8_STAGE(PG8_SB(0, 1), cB + hstep, voffB); PG8_STAGE(PG8_SA(0, 1), cA + hstep, voffA);
    if (wr == 1) PG8_BAR;
    PG8_WAIT_V(4); PG8_BAR;
    PG8_STAGE(PG8_SB(1, 0), cB + kstep, voffB); PG8_STAGE(PG8_SA(1, 0), cA + kstep, voffA); PG8_STAGE(PG8_SB(1, 1), cB + hstep + kstep, voffB);
    PG8_WAIT_V(6); PG8_BAR;
    for (;;) {
        const bool has_next = S.next(ui + 1, nxt);
        const char* nA = has_next ? (const char*)g.A + (size_t)nxt.pm * tstep : cA; const char* nB = has_next ? (const char*)g.Bt + (size_t)nxt.pn * tstep : cB;
        for (int t = 0; t < nt; t += 2) {
            const bool last = (t == nt - 2);
            const char* a1 = cA + (size_t)(t + 1) * kstep;
            const char* a2 = last ? nA : cA + (size_t)(t + 2) * kstep; const char* b2 = last ? nB : cB + (size_t)(t + 2) * kstep;
            const char* a3 = a2 + kstep; const char* b3 = b2 + kstep;
            PG8_LDB(B0, 0, 0); PG8_SCHED; PG8_LDA(At, 0, 0); PG8_STAGE(PG8_SA(1, 1), a1 + hstep, voffA);
            PG8_WAIT_L(8); PG8_BAR; PG8_WAIT_L(0); PG8_MMA(0, 0, At, B0); PG8_BAR; PG8_SCHED;
            PG8_LDB(B1, 0, 1); PG8_STAGE(PG8_SB(0, 0), b2, voffB);
            PG8_BAR; PG8_WAIT_L(0); PG8_MMA(0, 1, At, B1); PG8_BAR;
            PG8_LDA(At, 0, 1); PG8_STAGE(PG8_SA(0, 0), a2, voffA);
            PG8_BAR; PG8_WAIT_L(0); PG8_MMA(1, 0, At, B0); PG8_BAR; PG8_SCHED;
            PG8_STAGE(PG8_SB(0, 1), b2 + hstep, voffB);
            PG8_WAIT_V(6); PG8_BAR; PG8_MMA(1, 1, At, B1); PG8_BAR;
            PG8_LDB(B0, 1, 0); PG8_SCHED; PG8_LDA(At, 1, 0); PG8_STAGE(PG8_SA(0, 1), a2 + hstep, voffA);
            PG8_WAIT_L(8); PG8_BAR; PG8_WAIT_L(0); PG8_MMA(0, 0, At, B0); PG8_BAR; PG8_SCHED;
            PG8_LDB(B1, 1, 1); PG8_STAGE(PG8_SB(1, 0), b3, voffB);
            PG8_BAR; PG8_WAIT_L(0); PG8_MMA(0, 1, At, B1); PG8_BAR;
            PG8_LDA(At, 1, 1); PG8_STAGE(PG8_SA(1, 0), a3, voffA);
            PG8_BAR; PG8_WAIT_L(0); PG8_MMA(1, 0, At, B0); PG8_BAR; PG8_SCHED;
            PG8_STAGE(PG8_SB(1, 1), b3 + hstep, voffB);
            PG8_WAIT_V(6); PG8_BAR; PG8_MMA(1, 1, At, B1); PG8_BAR;
        }
        E(acc, cur, ui, wr, wc, fr, fq);
        if (!has_next) break;
#pragma unroll
        for (int a = 0; a < 2; ++a)
#pragma unroll
            for (int b = 0; b < 2; ++b)
#pragma unroll
                for (int m = 0; m < 4; ++m)
#pragma unroll
                    for (int n = 0; n < 2; ++n) acc[a][b][m][n] = (f32x4){0.f, 0.f, 0.f, 0.f};
        cur = nxt; cA = nA; cB = nB; ++ui;
    }
    PG8_WAIT_V(0);
    if (wr == 0) PG8_BAR;
    PG8_BAR;
#undef PG8_SA
#undef PG8_SB
#undef PG8_STAGE
#undef PG8_LDA
#undef PG8_LDB
#undef PG8_MMA
#undef PG8_WAIT_V
#undef PG8_WAIT_L
#undef PG8_BAR
#undef PG8_SCHED
}
}

__device__ __forceinline__ void pinf8(float (&v)[32], int o) {
    asm volatile("" : "+v"(v[o]), "+v"(v[o + 1]), "+v"(v[o + 2]), "+v"(v[o + 3]), "+v"(v[o + 4]), "+v"(v[o + 5]), "+v"(v[o + 6]), "+v"(v[o + 7]));
}
__device__ __forceinline__ void transpose_item(const float* W, int N, const float* kscale, const float* nscale, bf16_t* WT, int ldk, LAS float* scr, int item, int lane) {
    const int nblk = N / 32, kb = item / nblk, nb = item % nblk, k0 = 64 * kb, n0 = 32 * nb;
    const int c = lane & 7;
    float v[32];
    const float* src = W + (size_t)(k0 + (lane >> 5)) * N + n0 + (lane & 31);
#pragma unroll
    for (int i = 0; i < 32; ++i) v[i] = src[(size_t)(2 * i) * N];
    f32x4 ks0 = (f32x4){1.f, 1.f, 1.f, 1.f}, ks1 = ks0;
    if (kscale) { ks0 = *(const f32x4*)(kscale + k0 + 8 * c); ks1 = *(const f32x4*)(kscale + k0 + 8 * c + 4); }
    float nsv[4];
#pragma unroll
    for (int j = 0; j < 4; ++j) nsv[j] = nscale ? nscale[n0 + (lane >> 3) + 8 * j] : 1.0f;
    pinf8(v, 0); pinf8(v, 8); pinf8(v, 16); pinf8(v, 24);
#pragma unroll
    for (int i = 0; i < 32; ++i) scr[(2 * i + (lane >> 5)) * 33 + (lane & 31)] = v[i];
    asm volatile("s_waitcnt lgkmcnt(0)" ::: "memory");
#pragma unroll
    for (int j = 0; j < 4; ++j) { const int n = (lane >> 3) + 8 * j; const LAS float* s = scr + (8 * c) * 33 + n; const float ns = nsv[j];
        u32x4 o; o.x = pk2(s[0 * 33] * ks0[0] * ns, s[1 * 33] * ks0[1] * ns); o.y = pk2(s[2 * 33] * ks0[2] * ns, s[3 * 33] * ks0[3] * ns);
        o.z = pk2(s[4 * 33] * ks1[0] * ns, s[5 * 33] * ks1[1] * ns); o.w = pk2(s[6 * 33] * ks1[2] * ns, s[7 * 33] * ks1[3] * ns);
        *(u32x4*)(WT + (size_t)(n0 + n) * ldk + k0 + 8 * c) = o; }
    asm volatile("s_waitcnt lgkmcnt(0)" ::: "memory");
}

__device__ __forceinline__ void phase_prologue(KP p, LAS unsigned char* lds) {
    int tid = threadIdx.x; asm volatile("" : "+v"(tid));
    const int lane = tid & 63, wave = tid >> 6;
    const int gw = blockIdx.x * 8 + wave, NGW = gridDim.x * 8;
    LAS float* scr = (LAS float*)(lds + wave * 8448);
    unsigned char* ws = p->ws;
    constexpr int I_IN = 16 * 51, I_OUT = 16 * 32, I_FF1 = 16 * 128, I_FF2 = 64 * 32, I_PW = 4 * 8, I_UQ = 3 * 12, I_UKV = 2 * 16, I_POOL = 4 * 2;
    constexpr int I_LAYER = I_IN + I_OUT + I_FF1 + I_FF2 + I_PW + I_UQ + I_UKV + I_POOL;
    for (int it = gw; it < DEPTH * I_LAYER; it += NGW) {
        const int l = it / I_LAYER; int r = it % I_LAYER;
        if (r < I_IN) { transpose_item(p->w_in + (size_t)l * DM * DIN, DIN, p->mix_norm_g + l * DM, nullptr, (bf16_t*)(ws + OFF_WIN + l * SZ_WIN), DM, scr, r, lane); continue; } r -= I_IN;
        if (r < I_OUT) { transpose_item(p->w_out + (size_t)l * DM * DM, DM, p->group_norm_g + l * DM, nullptr, (bf16_t*)(ws + OFF_WOUT + l * SZ_WOUT), DM, scr, r, lane); continue; } r -= I_OUT;
        if (r < I_FF1) { transpose_item(p->w_ff1 + (size_t)l * DM * DFF, DFF, p->ffn_norm_g + l * DM, nullptr, (bf16_t*)(ws + OFF_W1 + l * SZ_W1), DM, scr, r, lane); continue; } r -= I_FF1;
        if (r < I_FF2) { transpose_item(p->w_ff2 + (size_t)l * DFF * DM, DM, nullptr, nullptr, (bf16_t*)(ws + OFF_W2 + l * SZ_W2), DFF, scr, r, lane); continue; } r -= I_FF2;
        if (r < I_PW) { transpose_item(p->conv_pw_w + (size_t)l * 256 * 256, 256, nullptr, nullptr, (bf16_t*)(ws + OFF_PW + l * SZ_PW), 256, scr, r, lane); continue; } r -= I_PW;
        if (r < I_UQ) { transpose_item(p->mla_w_uq + (size_t)l * 192 * 384, 384, p->mla_q_norm_g + l * 192, nullptr, (bf16_t*)(ws + OFF_UQ + l * SZ_UQ), 192, scr, r, lane); continue; } r -= I_UQ;
        if (r < I_UKV) { transpose_item(p->mla_w_ukv + (size_t)l * 128 * 512, 512, p->mla_kv_norm_g + l * 128, nullptr, (bf16_t*)(ws + OFF_UKV + l * SZ_UKV), 128, scr, r, lane); continue; } r -= I_UKV;
        { const int g = r >> 1, sub = r & 1;
          transpose_item(p->pool_w + (size_t)(l * 4 + g) * 64 * 64, 64, nullptr, p->pool_scale + l * 256 + g * 64, (bf16_t*)(ws + OFF_POOL + l * SZ_POOL) + g * 64 * 64, 64, scr, sub, lane); }
    }
    const int gt = blockIdx.x * 512 + tid, NGT = gridDim.x * 512;
    for (int i = gt; i < DEPTH * 160 * (DM / 8); i += NGT) { const int l = i / (160 * 128), r = i % (160 * 128);
        *(u32x4*)((bf16_t*)(ws + OFF_WIN + l * SZ_WIN) + (size_t)(DIN + r / 128) * DM + (r % 128) * 8) = (u32x4){0u, 0u, 0u, 0u}; }
    for (int i = gt; i < DEPTH * 4 * 128 * 128 / 2; i += NGT) { const int e = 2 * i, jj = e & 127, ii = (e >> 7) & 127; const f32x2 v = *(const f32x2*)(p->gmlp_ws + e);
        *(unsigned*)((bf16_t*)(ws + OFF_GWS) + e) = pk2(jj <= ii ? v[0] : 0.f, (jj + 1) <= ii ? v[1] : 0.f); }
    for (int i = gt; i < M_TOK * 16; i += NGT) { const int row = i >> 4, k = i & 15; const float ang = (float)p->positions[row] * INV_FREQ[k];
        const double a = (double)ang; const double n = rint(a * 0.15915494309189535); const float rr = (float)(a - n * 6.283185307179586);
        float* rt = (float*)(ws + OFF_ROPE) + (size_t)row * 32; rt[k] = cosf(rr); rt[16 + k] = sinf(rr); }
    for (int r4 = gw; r4 < M_TOK / 4; r4 += NGW) {
        u32x4 xv[16];
#pragma unroll
        for (int q = 0; q < 4; ++q)
#pragma unroll
            for (int j = 0; j < 4; ++j) xv[4 * q + j] = *((const u32x4*)(p->x + (size_t)(4 * r4 + q) * DM) + lane + 64 * j);
        pin(xv);
        float sv[4];
#pragma unroll
        for (int q = 0; q < 4; ++q) {
            u32x2* hr = (u32x2*)((bf16_t*)(ws + OFF_HB) + (size_t)(4 * r4 + q) * DM) + lane; float s = 0.f;
#pragma unroll
            for (int j = 0; j < 4; ++j) { const f32x4 v = __builtin_bit_cast(f32x4, xv[4 * q + j]); s += (v[0] * v[0] + v[1] * v[1]) + (v[2] * v[2] + v[3] * v[3]); u32x2 w2; w2.x = pk2(v[0], v[1]); w2.y = pk2(v[2], v[3]); hr[64 * j] = w2; }
            sv[q] = s;
        }
#pragma unroll
        for (int o = 1; o < 64; o <<= 1)
#pragma unroll
            for (int q = 0; q < 4; ++q) sv[q] += __shfl_xor(sv[q], o);
        const float mine = (lane >> 4) == 0 ? sv[0] : ((lane >> 4) == 1 ? sv[1] : ((lane >> 4) == 2 ? sv[2] : sv[3]));
        ((float*)(ws + OFF_SSQA))[(size_t)(4 * r4) * 16 + lane] = (lane & 15) == 0 ? mine : 0.f;
    }
}

constexpr int R1_BYTES = 88064, R2_OFF = R1_BYTES, R2_BYTES = 67584, R3_OFF = R2_OFF + R2_BYTES;
constexpr int YLD = 264, CQLD = 200, CKLD = 136, VLD = 136, CK_OFF = 128 * CQLD * 2, RS_OFF = CK_OFF + 128 * CKLD * 2;
static_assert(RS_OFF + 1024 <= R1_BYTES && R3_OFF + 8192 <= LDS_BYTES, "mixer LDS map");

template <int NKS, int NNT>
__device__ __forceinline__ void wgemm(f32x4 (&acc)[8][NNT], const LAS bf16_t* A, const int lda, const bf16_t* Bp, const int ldb) {
    u32x4 bf[NNT][NKS];
#pragma unroll
    for (int nt = 0; nt < NNT; ++nt) ldfr(bf[nt], Bp + (size_t)(16 * nt) * ldb);
#pragma unroll
    for (int nt = 0; nt < NNT; ++nt) pin(bf[nt]);
#pragma unroll
    for (int mt = 0; mt < 8; ++mt) {
        bf16x8 af[NKS];
#pragma unroll
        for (int ks = 0; ks < NKS; ++ks) af[ks] = *(const LAS bf16x8*)(A + (16 * mt) * lda + 32 * ks);
#pragma unroll
        for (int nt = 0; nt < NNT; ++nt) { f32x4 a = (f32x4){0.f, 0.f, 0.f, 0.f};
#pragma unroll
            for (int ks = 0; ks < NKS; ++ks) a = mfma16(as_bf16x8(bf[nt][ks]), af[ks], a);
            acc[mt][nt] = a; }
    }
}
template <int NNT>
__device__ __forceinline__ void part_sumsq(const f32x4 (&acc)[8][NNT], LAS float* part, int w, int fr, int fq) {
#pragma unroll
    for (int mt = 0; mt < 8; ++mt) { float s = 0.f;
#pragma unroll
        for (int nt = 0; nt < NNT; ++nt) s += (acc[mt][nt][0] * acc[mt][nt][0] + acc[mt][nt][1] * acc[mt][nt][1]) + (acc[mt][nt][2] * acc[mt][nt][2] + acc[mt][nt][3] * acc[mt][nt][3]);
        s += __shfl_xor(s, 16); s += __shfl_xor(s, 32);
        if (fq == 0) part[(16 * mt + fr) * 8 + w] = s; }
}
template <int NNT>
__device__ __forceinline__ void norm_store(const f32x4 (&acc)[8][NNT], const LAS float* part, bf16_t* dst, int fr) {
#pragma unroll
    for (int mt = 0; mt < 8; ++mt) {
        const LAS f32x4* pp = (const LAS f32x4*)(part + (16 * mt + fr) * 8); const f32x4 a = pp[0], b = pp[1];
        const float rs = rsq((((a[0] + a[1]) + (a[2] + a[3])) + ((b[0] + b[1]) + (b[2] + b[3]))) * (1.0f / 256.0f) + EPS);
#pragma unroll
        for (int nt = 0; nt < NNT; ++nt) { u32x2 o; o.x = pk2(acc[mt][nt][0] * rs, acc[mt][nt][1] * rs); o.y = pk2(acc[mt][nt][2] * rs, acc[mt][nt][3] * rs);
            *(u32x2*)(dst + (size_t)(16 * mt) * DM + 16 * nt) = o; }
    }
}

__device__ __forceinline__ void mixer_chunk(KP p, LAS unsigned char* lds, int l, int chunk) {
    int tid = threadIdx.x; asm volatile("" : "+v"(tid));
    const int lane = tid & 63, w = __builtin_amdgcn_readfirstlane(tid >> 6), fr = lane & 15, fq = lane >> 4;
    unsigned char* ws = p->ws;
    const bf16_t* zb = (const bf16_t*)(ws + OFF_ZB);
    bf16_t* mixed = (bf16_t*)(ws + OFF_MIX);
    const int c0 = chunk * 128, bidx = chunk >> 5, s0 = (chunk & 31) * 128;
    LAS bf16_t* Y = (LAS bf16_t*)lds; LAS bf16_t* CO = (LAS bf16_t*)(lds + R2_OFF); LAS bf16_t* VT = (LAS bf16_t*)lds;
    LAS bf16_t* CQ = (LAS bf16_t*)lds; LAS bf16_t* CK = (LAS bf16_t*)(lds + CK_OFF); LAS float* RSQ = (LAS float*)(lds + RS_OFF); LAS float* RSK = RSQ + 128;
    LAS bf16_t* ZP = (LAS bf16_t*)lds; LAS bf16_t* YP = (LAS bf16_t*)(lds + R2_OFF);
    LAS float* part0 = (LAS float*)(lds + R3_OFF); LAS float* part1 = part0 + 1024;
    bf16_t* mrow = mixed + (size_t)(c0 + fr) * DM + 4 * fq;

#pragma unroll 1
    for (int half = 0; half < 2; ++half) {
        u32x4 av[5], gv[5];
#pragma unroll
        for (int i = 0; i < 5; ++i) {
            const int q = tid + 512 * (5 * half + i); int r = q >> 5; r = r < 158 ? r : 157; const int cc = (q & 31) * 8;
            const int rr = (s0 - 30 + r >= 0) ? (c0 - 30 + r) : c0;
            const bf16_t* zq = zb + (size_t)rr * DIN_P + cc; av[i] = *(const u32x4*)zq; gv[i] = *(const u32x4*)(zq + ZC_G);
        }
        pin(av); pin(gv);
#pragma unroll
        for (int i = 0; i < 5; ++i) {
            const int q = tid + 512 * (5 * half + i); const int r = q >> 5, cc = (q & 31) * 8;
            u32x4 o;
#pragma unroll
            for (int e = 0; e < 4; ++e) o[e] = pk2(bf_lo(av[i][e]) * sigmoidf_(bf_lo(gv[i][e])), bf_hi(av[i][e]) * sigmoidf_(bf_hi(gv[i][e])));
            if (s0 - 30 + r < 0) o = (u32x4){0u, 0u, 0u, 0u};
            if (r < 158) *(LAS u32x4*)(Y + r * YLD + cc) = o;
        }
    }
    __syncthreads();
    {
        const int hc = w & 1, tq = w >> 1, c = 128 * hc + 2 * lane;
        const float* dw = p->conv_dw_w + (size_t)l * 31 * 256 + c;
        float w0[31], w1[31];
#pragma unroll
        for (int j = 0; j < 31; ++j) { const f32x2 ww = *(const f32x2*)(dw + j * 256); w0[j] = ww[0]; w1[j] = ww[1]; }
        const f32x2 bb = *(const f32x2*)(p->conv_dw_b + l * 256 + c);
#pragma unroll 1
        for (int blk = 0; blk < 4; ++blk) {
            const int t0 = 32 * tq + 8 * blk;
            float a0[8], a1[8];
#pragma unroll
            for (int o = 0; o < 8; ++o) { a0[o] = bb[0]; a1[o] = bb[1]; }
#pragma unroll
            for (int r = 0; r < 38; ++r) {
                const unsigned yv = *(const LAS unsigned*)(Y + (t0 + r) * YLD + c); const float y0 = bf_lo(yv), y1 = bf_hi(yv);
#pragma unroll
                for (int o = 0; o < 8; ++o) { const int j = r - o; if (j >= 0 && j <= 30) { a0[o] += w0[j] * y0; a1[o] += w1[j] * y1; } }
            }
#pragma unroll
            for (int o = 0; o < 8; ++o) *(LAS unsigned*)(CO + (t0 + o) * YLD + c) = pk2(a0[o], a1[o]);
        }
    }
    __syncthreads();
    u32x4 sq[6], sk[4];
#pragma unroll
    for (int i = 0; i < 6; ++i) { const int q = tid + 512 * i, r = q / 24, pc = q % 24; sq[i] = *(const u32x4*)(zb + (size_t)(c0 + r) * DIN_P + ZC_CQ + 8 * pc); }
#pragma unroll
    for (int i = 0; i < 4; ++i) { const int q = tid + 512 * i, r = q >> 4, pc = q & 15; sk[i] = *(const u32x4*)(zb + (size_t)(c0 + r) * DIN_P + ZC_CKV + 8 * pc); }
    {
        const f32x4 lg = *(const f32x4*)(p->conv_ln_g + l * 256 + 4 * lane), lb = *(const f32x4*)(p->conv_ln_b + l * 256 + 4 * lane);
#pragma unroll 1
        for (int half = 0; half < 2; ++half) {
            f32x4 x[8]; float s[8];
#pragma unroll
            for (int i = 0; i < 8; ++i) { const u32x2 v = *(const LAS u32x2*)(CO + (16 * w + 8 * half + i) * YLD + 4 * lane);
                x[i] = (f32x4){bf_lo(v.x), bf_hi(v.x), bf_lo(v.y), bf_hi(v.y)}; s[i] = (x[i][0] + x[i][1]) + (x[i][2] + x[i][3]); }
#pragma unroll
            for (int o = 1; o < 64; o <<= 1)
#pragma unroll
                for (int i = 0; i < 8; ++i) s[i] += __shfl_xor(s[i], o);
#pragma unroll
            for (int i = 0; i < 8; ++i) { x[i] = x[i] - s[i] * (1.0f / 256.0f); s[i] = (x[i][0] * x[i][0] + x[i][1] * x[i][1]) + (x[i][2] * x[i][2] + x[i][3] * x[i][3]); }
#pragma unroll
            for (int o = 1; o < 64; o <<= 1)
#pragma unroll
                for (int i = 0; i < 8; ++i) s[i] += __shfl_xor(s[i], o);
#pragma unroll
            for (int i = 0; i < 8; ++i) {
                const float rstd = rsq(s[i] * (1.0f / 256.0f) + EPS);
                f32x4 y = x[i] * rstd * lg + lb;
#pragma unroll
                for (int j = 0; j < 4; ++j) y[j] = y[j] * sigmoidf_(y[j]);
                u32x2 o; o.x = pk2(y[0], y[1]); o.y = pk2(y[2], y[3]); *(LAS u32x2*)(CO + (16 * w + 8 * half + i) * YLD + 4 * lane) = o;
            }
        }
    }
    pin(sq); pin(sk);
#pragma unroll
    for (int i = 0; i < 6; ++i) { const int q = tid + 512 * i, r = q / 24, pc = q % 24; *(LAS u32x4*)(CQ + r * CQLD + 8 * pc) = sq[i]; }
#pragma unroll
    for (int i = 0; i < 4; ++i) { const int q = tid + 512 * i, r = q >> 4, pc = q & 15; *(LAS u32x4*)(CK + r * CKLD + 8 * pc) = sk[i]; }
    __syncthreads();
    f32x4 accc[8][2];
    wgemm<8, 2>(accc, CO + fr * YLD + 8 * fq, YLD, (const bf16_t*)(ws + OFF_PW + l * SZ_PW) + (size_t)(32 * w + fr) * 256 + 8 * fq, 256);
    part_sumsq<2>(accc, part0, w, fr, fq);
    {
        float ssq_ = 0.f, ssk = 0.f;
#pragma unroll
        for (int ks = 0; ks < 6; ++ks) ssq_ += sumsq8(*(const LAS u32x4*)(CQ + (16 * w + fr) * CQLD + 32 * ks + 8 * fq));
#pragma unroll
        for (int ks = 0; ks < 4; ++ks) ssk += sumsq8(*(const LAS u32x4*)(CK + (16 * w + fr) * CKLD + 32 * ks + 8 * fq));
        ssq_ += __shfl_xor(ssq_, 16); ssq_ += __shfl_xor(ssq_, 32); ssk += __shfl_xor(ssk, 16); ssk += __shfl_xor(ssk, 32);
        if (fq == 0) { RSQ[16 * w + fr] = QSCALE * rsq(ssq_ * (1.0f / 192.0f) + EPS); RSK[16 * w + fr] = rsq(ssk * (1.0f / 128.0f) + EPS); }
        const int row = c0 + 16 * w + fr, spos = s0 + 16 * w + fr;
        const bf16_t* zr = zb + (size_t)row * DIN_P; const float* rt = (const float*)(ws + OFF_ROPE) + (size_t)row * 32;
        const u32x2 r1 = *(const u32x2*)(zr + ZC_KR + 4 * fq), r2 = *(const u32x2*)(zr + ZC_KR + 16 + 4 * fq);
        const f32x4 cs = *(const f32x4*)(rt + 4 * fq), sn = *(const f32x4*)(rt + 16 + 4 * fq);
        const f32x4 k1 = (f32x4){bf_lo(r1.x), bf_hi(r1.x), bf_lo(r1.y), bf_hi(r1.y)}, k2 = (f32x4){bf_lo(r2.x), bf_hi(r2.x), bf_lo(r2.y), bf_hi(r2.y)};
        const f32x4 o1 = k1 * cs - k2 * sn, o2 = k2 * cs + k1 * sn;
        u32x2 ro1, ro2; ro1.x = pk2(o1[0], o1[1]); ro1.y = pk2(o1[2], o1[3]); ro2.x = pk2(o2[0], o2[1]); ro2.y = pk2(o2[2], o2[3]);
        bf16_t* kd = (bf16_t*)(ws + OFF_K) + ((size_t)(bidx * 4) * SEQ + spos) * 96 + 64 + 4 * fq;
#pragma unroll
        for (int h = 0; h < 4; ++h) { *(u32x2*)(kd + (size_t)h * SEQ * 96) = ro1; *(u32x2*)(kd + (size_t)h * SEQ * 96 + 16) = ro2; }
    }
    __syncthreads();
    norm_store<2>(accc, part0, mrow + 0 + 32 * w, fr);
    {
        f32x4 acc[8][3];
        wgemm<6, 3>(acc, CQ + fr * CQLD + 8 * fq, CQLD, (const bf16_t*)(ws + OFF_UQ + l * SZ_UQ) + (size_t)(48 * w + fr) * 192 + 8 * fq, 192);
        const int head = (3 * w) / 6, d0 = 16 * ((3 * w) % 6);
        u32x4 csn[16];
        if (w & 1) {
#pragma unroll
            for (int mt = 0; mt < 8; ++mt) { const float* rt = (const float*)(ws + OFF_ROPE) + (size_t)(c0 + 16 * mt + fr) * 32 + 4 * fq; csn[2 * mt] = *(const u32x4*)rt; csn[2 * mt + 1] = *(const u32x4*)(rt + 16); }
            pin(csn);
        }
#pragma unroll
        for (int mt = 0; mt < 8; ++mt) {
            const float rs = RSQ[16 * mt + fr];
            f32x4 a0 = acc[mt][0] * rs, a1 = acc[mt][1] * rs, a2 = acc[mt][2] * rs;
            if (w & 1) { const f32x4 cs = __builtin_bit_cast(f32x4, csn[2 * mt]), sn = __builtin_bit_cast(f32x4, csn[2 * mt + 1]); const f32x4 x1 = a1, x2 = a2; a1 = x1 * cs - x2 * sn; a2 = x2 * cs + x1 * sn; }
            bf16_t* qd = (bf16_t*)(ws + OFF_Q) + ((size_t)(bidx * 4 + head) * SEQ + s0 + 16 * mt + fr) * 96 + d0 + 4 * fq;
            u32x2 o; o.x = pk2(a0[0], a0[1]); o.y = pk2(a0[2], a0[3]); *(u32x2*)(qd) = o;
            o.x = pk2(a1[0], a1[1]); o.y = pk2(a1[2], a1[3]); *(u32x2*)(qd + 16) = o;
            o.x = pk2(a2[0], a2[1]); o.y = pk2(a2[2], a2[3]); *(u32x2*)(qd + 32) = o;
        }
    }
#pragma unroll 1
    for (int pz = 0; pz < 2; ++pz) {
        f32x4 acc[8][2];
        wgemm<4, 2>(acc, CK + fr * CKLD + 8 * fq, CKLD, (const bf16_t*)(ws + OFF_UKV + l * SZ_UKV) + (size_t)(64 * w + 32 * pz + fr) * 128 + 8 * fq, 128);
        const int head = w >> 1;
#pragma unroll
        for (int mt = 0; mt < 8; ++mt) {
            const float rs = RSK[16 * mt + fr]; const int spos = s0 + 16 * mt + fr;
#pragma unroll
            for (int n = 0; n < 2; ++n) {
                const f32x4 a = acc[mt][n] * rs; const unsigned p0 = pk2(a[0], a[1]), p1 = pk2(a[2], a[3]);
                if ((w & 1) == 0) { u32x2 o; o.x = p0; o.y = p1; *(u32x2*)((bf16_t*)(ws + OFF_K) + ((size_t)(bidx * 4 + head) * SEQ + spos) * 96 + 16 * (2 * pz + n) + 4 * fq) = o; }
                else { const int fp = ((fr & 4) << 1) | ((fr & 8) >> 1) | (fr & 3);
                    bf16_t* vv = (bf16_t*)(ws + OFF_VT) + ((size_t)(bidx * 4 + head) * 64 + 16 * (2 * pz + n) + 4 * fq) * SEQ + (spos - fr + fp);
                    vv[0] = (bf16_t)(p0 & 0xffff); vv[SEQ] = (bf16_t)(p0 >> 16); vv[2 * SEQ] = (bf16_t)(p1 & 0xffff); vv[3 * SEQ] = (bf16_t)(p1 >> 16); }
            }
        }
    }
    __syncthreads();
    {
        u32x4 zv[9];
#pragma unroll
        for (int i = 0; i < 9; ++i) { int q = tid + 512 * i; q = q < 143 * 32 ? q : 143 * 32 - 1; const int r = q >> 5, pc = q & 31; const int rr = (s0 - 15 + r >= 0) ? (c0 - 15 + r) : c0;
            zv[i] = *(const u32x4*)(zb + (size_t)rr * DIN_P + ZC_POOL + 8 * pc); }
        { u32x4 (&z8)[8] = *(u32x4 (*)[8])&zv[0]; pin(z8); }
#pragma unroll
        for (int i = 0; i < 9; ++i) { const int q = tid + 512 * i; if (q < 143 * 32) *(LAS u32x4*)(ZP + (q >> 5) * YLD + 8 * (q & 31)) = zv[i]; }
    }
    __syncthreads();
#pragma unroll
    for (int i = 0; i < 8; ++i) {
        const int g = i & 3, W = 2 << g, idx = tid + 512 * (i >> 2), r = idx >> 3, pc = 8 * g + (idx & 7);
        const int spos = s0 + r; const int cnt = (spos + 1) < W ? (spos + 1) : W; const float inv = 1.0f / (float)cnt;
        const LAS bf16_t* zp = ZP + (r + 15) * YLD + 8 * pc;
        float sum[8];
#pragma unroll
        for (int e = 0; e < 8; ++e) sum[e] = 0.f;
        const u32x4 self = *(const LAS u32x4*)zp;
#pragma unroll
        for (int j = 0; j < W; ++j) { const u32x4 v = *(const LAS u32x4*)(zp - j * YLD); const float m = j < cnt ? 1.f : 0.f;
#pragma unroll
            for (int e = 0; e < 4; ++e) { sum[2 * e] += m * bf_lo(v[e]); sum[2 * e + 1] += m * bf_hi(v[e]); } }
        u32x4 yv;
#pragma unroll
        for (int e = 0; e < 4; ++e) yv[e] = pk2(sum[2 * e] * inv - bf_lo(self[e]), sum[2 * e + 1] * inv - bf_hi(self[e]));
        *(LAS u32x4*)(YP + r * YLD + 8 * pc) = yv;
    }
    u32x4 vv[8];
    {
        const bf16_t* vr = zb + (size_t)(c0 + 16 * w + (lane >> 2)) * DIN_P + ZC_V + 64 * (lane & 3);
#pragma unroll
        for (int i = 0; i < 8; ++i) vv[i] = *(const u32x4*)(vr + 8 * i);
    }
    __syncthreads();
    f32x4 accp[8][2];
    {
        const int g = w >> 1, t0 = 2 * (w & 1);
        wgemm<2, 2>(accp, YP + fr * YLD + 64 * g + 8 * fq, YLD, (const bf16_t*)(ws + OFF_POOL + l * SZ_POOL) + (size_t)(64 * g + 16 * t0 + fr) * 64 + 8 * fq, 64);
        part_sumsq<2>(accp, part1, w, fr, fq);
    }
    {
        pin(vv);
        const int j = 16 * w + (lane >> 2), q4 = lane & 3; float ss = 0.f;
#pragma unroll
        for (int i = 0; i < 8; ++i) ss += sumsq8(vv[i]);
        ss += __shfl_xor(ss, 1); ss += __shfl_xor(ss, 2);
        const float rs = rsq(ss * (1.0f / 256.0f) + EPS);
        const float* gg = p->gmlp_norm_g + l * 256 + 64 * q4;
#pragma unroll
        for (int i = 0; i < 8; ++i) {
            const f32x4 g0 = *(const f32x4*)(gg + 8 * i), g1 = *(const f32x4*)(gg + 8 * i + 4);
#pragma unroll
            for (int e = 0; e < 4; ++e) { const int d = 8 * i + 2 * e; const float ga = e < 2 ? g0[2 * e] : g1[2 * e - 4], gb = e < 2 ? g0[2 * e + 1] : g1[2 * e - 3];
                const unsigned pk = pk2(bf_lo(vv[i][e]) * rs * ga, bf_hi(vv[i][e]) * rs * gb);
                VT[(64 * q4 + d) * VLD + j] = (bf16_t)(pk & 0xffff); VT[(64 * q4 + d + 1) * VLD + j] = (bf16_t)(pk >> 16); }
        }
    }
    __syncthreads();
    norm_store<2>(accp, part1, mrow + 512 + 64 * (w >> 1) + 32 * (w & 1), fr);
    {
        const int h = w >> 1, t0 = 2 * (w & 1);
        bf16x8 vf[2][4];
#pragma unroll
        for (int n = 0; n < 2; ++n)
#pragma unroll
            for (int ks = 0; ks < 4; ++ks) vf[n][ks] = *(const LAS bf16x8*)(VT + (64 * h + 16 * (t0 + n) + fr) * VLD + 32 * ks + 8 * fq);
        const bf16_t* gwp = (const bf16_t*)(ws + OFF_GWS + l * SZ_GWS) + (size_t)(h * 128 + fr) * 128 + 8 * fq;
        u32x2 uu[16]; float bias[8];
#pragma unroll
        for (int mt = 0; mt < 8; ++mt) {
            bias[mt] = p->gmlp_bs[(l * 4 + h) * 128 + 16 * mt + fr];
#pragma unroll
            for (int n = 0; n < 2; ++n) uu[2 * mt + n] = *(const u32x2*)(zb + (size_t)(c0 + 16 * mt + fr) * DIN_P + ZC_U + 64 * h + 16 * (t0 + n) + 4 * fq);
        }
        f32x4 acc[8][2];
#pragma unroll
        for (int mp = 0; mp < 4; ++mp) {
            u32x4 wf[8];
#pragma unroll
            for (int q = 0; q < 2; ++q)
#pragma unroll
                for (int ks = 0; ks < 4; ++ks) wf[4 * q + ks] = *(const u32x4*)(gwp + (size_t)(16 * (2 * mp + q)) * 128 + 32 * (ks <= mp ? ks : 0));
            pin(wf);
#pragma unroll
            for (int q = 0; q < 2; ++q)
#pragma unroll
                for (int n = 0; n < 2; ++n) { f32x4 a = (f32x4){0.f, 0.f, 0.f, 0.f};
#pragma unroll
                    for (int ks = 0; ks < 4; ++ks) if (ks <= mp) a = mfma16(vf[n][ks], as_bf16x8(wf[4 * q + ks]), a);
                    const int mt = 2 * mp + q; const u32x2 u2 = uu[2 * mt + n]; const float bs_ = bias[mt];
                    a[0] = bf_lo(u2.x) * (a[0] + bs_); a[1] = bf_hi(u2.x) * (a[1] + bs_); a[2] = bf_lo(u2.y) * (a[2] + bs_); a[3] = bf_hi(u2.y) * (a[3] + bs_);
                    acc[mt][n] = a; }
        }
        part_sumsq<2>(acc, part0, w, fr, fq);
        __syncthreads();
        norm_store<2>(acc, part0, mrow + 768 + 64 * h + 16 * t0, fr);
    }
    __syncthreads();
}

constexpr int KLD = 104, VSLD = 136, KS_BYTES = 128 * KLD * 2, VS_BYTES = 64 * VSLD * 2, KV_BUF = KS_BYTES + VS_BYTES;

__device__ __forceinline__ void attn_block(KP p, LAS unsigned char* lds, int bh, int q0) {
    int tid = threadIdx.x; asm volatile("" : "+v"(tid));
    const int lane = tid & 63, w = __builtin_amdgcn_readfirstlane(tid >> 6), lr = lane & 31, lh = lane >> 5;
    unsigned char* ws = p->ws;
    const bf16_t* Qg = (const bf16_t*)(ws + OFF_Q) + (size_t)bh * SEQ * 96;
    const bf16_t* Kg = (const bf16_t*)(ws + OFF_K) + (size_t)bh * SEQ * 96;
    const bf16_t* Vg = (const bf16_t*)(ws + OFF_VT) + (size_t)bh * 64 * SEQ;
    const int qrow = q0 + 32 * w + lr, wave_q0 = q0 + 32 * w;
    bf16x8 qf[6];
#pragma unroll
    for (int ks = 0; ks < 6; ++ks) qf[ks] = *(const bf16x8*)(Qg + (size_t)qrow * 96 + 16 * ks + 8 * lh);
    f32x16 o0, o1;
#pragma unroll
    for (int i = 0; i < 16; ++i) { o0[i] = 0.f; o1[i] = 0.f; }
    float mrun = -1e30f, lrun = 0.f;
    const int nst = (q0 + 256) / 128;
    u32x4 rk[3], rv[2];
#pragma unroll
    for (int i = 0; i < 3; ++i) { const int q = tid + 512 * i; rk[i] = *(const u32x4*)(Kg + (size_t)(q / 12) * 96 + 8 * (q % 12)); }
#pragma unroll
    for (int i = 0; i < 2; ++i) { const int q = tid + 512 * i; rv[i] = *(const u32x4*)(Vg + (size_t)(q >> 4) * SEQ + 8 * (q & 15)); }
    for (int st = 0; st < nst; ++st) {
        LAS bf16_t* ksm0 = (LAS bf16_t*)(lds + (st & 1) * KV_BUF); LAS bf16_t* vsm0 = (LAS bf16_t*)(lds + (st & 1) * KV_BUF + KS_BYTES);
#pragma unroll
        for (int i = 0; i < 3; ++i) { const int q = tid + 512 * i; *(LAS u32x4*)(ksm0 + (q / 12) * KLD + 8 * (q % 12)) = rk[i]; }
#pragma unroll
        for (int i = 0; i < 2; ++i) { const int q = tid + 512 * i; *(LAS u32x4*)(vsm0 + (q >> 4) * VSLD + 8 * (q & 15)) = rv[i]; }
        if (st + 1 < nst) {
            const int k1 = 128 * (st + 1);
#pragma unroll
            for (int i = 0; i < 3; ++i) { const int q = tid + 512 * i; rk[i] = *(const u32x4*)(Kg + (size_t)(k1 + q / 12) * 96 + 8 * (q % 12)); }
#pragma unroll
            for (int i = 0; i < 2; ++i) { const int q = tid + 512 * i; rv[i] = *(const u32x4*)(Vg + (size_t)(q >> 4) * SEQ + k1 + 8 * (q & 15)); }
        }
        __syncthreads();
#pragma unroll
        for (int sub = 0; sub < 2; ++sub) {
        const int kt = 2 * st + sub;
        const LAS bf16_t* ksm = ksm0 + 64 * sub * KLD; const LAS bf16_t* vsm = vsm0 + 64 * sub;
        if (64 * kt <= wave_q0 + 31) {
            f32x16 s0, s1;
#pragma unroll
            for (int i = 0; i < 16; ++i) { s0[i] = 0.f; s1[i] = 0.f; }
            u32x4 ka[6], kb[6];
#pragma unroll
            for (int ks = 0; ks < 6; ++ks) { ka[ks] = *(const LAS u32x4*)(ksm + lr * KLD + 16 * ks + 8 * lh); kb[ks] = *(const LAS u32x4*)(ksm + (32 + lr) * KLD + 16 * ks + 8 * lh); }
            pin(ka); pin(kb);
#pragma unroll
            for (int ks = 0; ks < 6; ++ks) { s0 = mfma32(as_bf16x8(ka[ks]), qf[ks], s0); s1 = mfma32(as_bf16x8(kb[ks]), qf[ks], s1); }
            u32x4 va[4], vb[4];
#pragma unroll
            for (int q = 0; q < 4; ++q) { const LAS bf16_t* vp = vsm + lr * VSLD + 16 * q + 8 * lh; va[q] = *(const LAS u32x4*)vp; vb[q] = *(const LAS u32x4*)(vp + 32 * VSLD); }
            if (64 * kt + 63 > wave_q0) {
#pragma unroll
                for (int i = 0; i < 16; ++i) { const int key = 64 * kt + (i & 3) + 8 * (i >> 2) + 4 * lh;
                    if (key > qrow) s0[i] = -1e30f; if (key + 32 > qrow) s1[i] = -1e30f; }
            }
            float mx = s0[0];
#pragma unroll
            for (int i = 1; i < 16; ++i) mx = fmaxf(mx, s0[i]);
#pragma unroll
            for (int i = 0; i < 16; ++i) mx = fmaxf(mx, s1[i]);
            mx = fmaxf(mx, __shfl_xor(mx, 32));
            if (__builtin_amdgcn_ballot_w64(mx > mrun) != 0ull) {
                const float mnew = fmaxf(mrun, mx), alpha = fast_exp2(mrun - mnew);
                lrun *= alpha; mrun = mnew; o0 = o0 * alpha; o1 = o1 * alpha;
            }
            float rsum = 0.f;
#pragma unroll
            for (int i = 0; i < 16; ++i) { s0[i] = fast_exp2(s0[i] - mrun); s1[i] = fast_exp2(s1[i] - mrun); rsum += s0[i] + s1[i]; }
            lrun += rsum;
            pin(va); pin(vb);
#pragma unroll
            for (int q = 0; q < 4; ++q) {
                u32x4 pw;
#pragma unroll
                for (int e = 0; e < 4; ++e) pw[e] = (q >> 1) == 0 ? pk2(s0[8 * (q & 1) + 2 * e], s0[8 * (q & 1) + 2 * e + 1]) : pk2(s1[8 * (q & 1) + 2 * e], s1[8 * (q & 1) + 2 * e + 1]);
                const bf16x8 pf = as_bf16x8(pw);
                o0 = mfma32(as_bf16x8(va[q]), pf, o0); o1 = mfma32(as_bf16x8(vb[q]), pf, o1);
            }
        }
        }
    }
    const float ltot = lrun + __shfl_xor(lrun, 32), inv = fast_rcp(ltot);
    o0 = o0 * inv; o1 = o1 * inv;
    float ss = 0.f;
#pragma unroll
    for (int i = 0; i < 16; ++i) ss += o0[i] * o0[i] + o1[i] * o1[i];
    ss += __shfl_xor(ss, 32);
    const int b = bh >> 2, hd = bh & 3; const size_t grow = (size_t)b * SEQ + qrow;
    if (lh == 0) ((float*)(ws + OFF_SSQM))[grow * 4 + hd] = ss;
    bf16_t* od = (bf16_t*)(ws + OFF_MIX) + grow * DM + 256 + 64 * hd + 4 * lh;
#pragma unroll
    for (int g = 0; g < 4; ++g) {
        u32x2 a, c; a.x = pk2(o0[4 * g], o0[4 * g + 1]); a.y = pk2(o0[4 * g + 2], o0[4 * g + 3]); c.x = pk2(o1[4 * g], o1[4 * g + 1]); c.y = pk2(o1[4 * g + 2], o1[4 * g + 3]);
        *(u32x2*)(od + 8 * g) = a; *(u32x2*)(od + 32 + 8 * g) = c;
    }
    __syncthreads();
}


__device__ __forceinline__ void grid_barrier(unsigned* ctr, unsigned k, unsigned nwg) {
    asm volatile("s_waitcnt vmcnt(0) lgkmcnt(0)" ::: "memory");
    __syncthreads();
    if (threadIdx.x == 0) {
        unsigned* gen = ctr + 64;
        __builtin_amdgcn_fence(__ATOMIC_RELEASE, "agent");
        asm volatile("s_waitcnt vmcnt(0)" ::: "memory");
        const unsigned old = __hip_atomic_fetch_add(ctr, 1u, __ATOMIC_RELAXED, __HIP_MEMORY_SCOPE_AGENT);
        if (old + 1u == k * nwg) __hip_atomic_store(gen, k, __ATOMIC_RELAXED, __HIP_MEMORY_SCOPE_AGENT);
        else { unsigned spins = 0; while (__hip_atomic_load(gen, __ATOMIC_RELAXED, __HIP_MEMORY_SCOPE_AGENT) < k) { __builtin_amdgcn_s_sleep(2); if (++spins > (1u << 24)) break; } }
        __builtin_amdgcn_fence(__ATOMIC_ACQUIRE, "agent");
        asm volatile("s_waitcnt vmcnt(0)" ::: "memory");
    }
    __syncthreads();
}

__global__ void __launch_bounds__(512) fwd_kernel(Params p_arg) {
    extern __shared__ __attribute__((aligned(16))) unsigned char smem[];
    LAS unsigned char* lds = (LAS unsigned char*)smem;
    cg::grid_group grid = cg::this_grid();
    const int ph_lo = p_arg.ph_lo, ph_hi = p_arg.ph_hi;
    unsigned nbar = 0;
    if (ph_lo < 0) grid.sync();
    for (int ph = ph_lo; ph < ph_hi; ++ph)
    for (int rep = 0; rep < 1 + ((DUP_MASK >> (ph == 0 ? 0 : (ph == 1 + 7 * DEPTH ? 31 : 1 + (ph - 1) % 7))) & 1); ++rep) {
        if (ph > ph_lo || rep > 0) {
            ++nbar;
            grid_barrier((unsigned*)(p_arg.ws + OFF_BAR), nbar, gridDim.x);
        }
        KP p = (KP)__builtin_amdgcn_kernarg_segment_ptr();
        asm volatile("" : "+s"(p));
        unsigned char* ws = p->ws;
        int tid = threadIdx.x; asm volatile("" : "+v"(tid));
        const int lane = tid & 63, wave = tid >> 6;
        const int gw = blockIdx.x * 8 + wave, NGW = gridDim.x * 8;
        if (ph == 0) {
#if PH_MASK & 1
 phase_prologue(p, lds);
#endif
 continue; }
        if (ph == 1 + 7 * DEPTH) {
            const float* ssq = (const float*)(ws + OFF_SSQA);
            for (int r4 = gw; r4 < M_TOK / 4; r4 += NGW) {
                u32x4 xv[8];
#pragma unroll
                for (int q = 0; q < 4; ++q)
#pragma unroll
                    for (int j = 0; j < 2; ++j) xv[2 * q + j] = *((const u32x4*)((const bf16_t*)(ws + OFF_HB) + (size_t)(4 * r4 + q) * DM) + lane + 64 * j);
                float sp = ssq[(size_t)(4 * r4) * 16 + lane];
                pin(xv);
                sp += __shfl_xor(sp, 1); sp += __shfl_xor(sp, 2); sp += __shfl_xor(sp, 4); sp += __shfl_xor(sp, 8);
                const float rsl = rsq(sp * (1.0f / DM) + EPS);
#pragma unroll
                for (int q = 0; q < 4; ++q) {
                    const float rs = __shfl(rsl, 16 * q);
#pragma unroll
                    for (int j = 0; j < 2; ++j) {
                        const f32x4* gg = (const f32x4*)(p->final_norm_g + 512 * j + 8 * lane); const f32x4 g0 = gg[0], g1 = gg[1]; const u32x4 v = xv[2 * q + j];
                        f32x4* orow = (f32x4*)(p->out + (size_t)(4 * r4 + q) * DM + 512 * j + 8 * lane);
                        orow[0] = (f32x4){bf_lo(v.x) * rs * g0[0], bf_hi(v.x) * rs * g0[1], bf_lo(v.y) * rs * g0[2], bf_hi(v.y) * rs * g0[3]};
                        orow[1] = (f32x4){bf_lo(v.z) * rs * g1[0], bf_hi(v.z) * rs * g1[1], bf_lo(v.w) * rs * g1[2], bf_hi(v.w) * rs * g1[3]};
                    }
                }
            }
            continue;
        }
        const int l = (ph - 1) / 7, sub = (ph - 1) % 7;
        pg8::StaticOrder S;
#if PH_MASK & 2
        if (sub == 0) {
            pg8::Gemm g{(const bf16_t*)(ws + OFF_HB), (const bf16_t*)(ws + OFF_WIN + l * SZ_WIN), M_TOK, DIN_P, DM};
            S.init(M_TOK, DIN_P, gridDim.x, blockIdx.x);
            LAS float* rstab = (LAS float*)(lds + pg8::STAGE_BYTES);
            pg8::build_rs_table(rstab, S, (const float*)(ws + OFF_SSQA));
            pg8::EpiScaleBf16<0> E{(bf16_t*)(ws + OFF_ZB), DIN_P, rstab};
            pg8::gemm_phase(lds, g, S, E);
        } else
#endif
#if PH_MASK & 4
        if (sub == 1) {
            for (int ch = blockIdx.x; ch < M_TOK / 128; ch += gridDim.x) mixer_chunk(p, lds, l, ch);
        } else
#endif
#if PH_MASK & 8
        if (sub == 2) {
            for (int it0 = blockIdx.x; it0 < 256; it0 += gridDim.x) { const int it = (it0 & 7) * 32 + (it0 >> 3);
                const int bh = it >> 3, pr = it & 7; attn_block(p, lds, bh, 256 * pr); attn_block(p, lds, bh, 256 * (15 - pr)); }
        } else
#endif
        if (sub == 3) {
            const float* sm = (const float*)(ws + OFF_SSQM); bf16_t* mixed = (bf16_t*)(ws + OFF_MIX);
            for (int r8 = gw; r8 < M_TOK / 8; r8 += NGW) {
                u32x4 mv[4]; f32x4 s4[4];
#pragma unroll
                for (int q = 0; q < 4; ++q) { const int row = 8 * r8 + 2 * q + (lane >> 5); s4[q] = *(const f32x4*)(sm + (size_t)row * 4); mv[q] = *(const u32x4*)(mixed + (size_t)row * DM + 256 + 8 * (lane & 31)); }
                pin(mv);
#pragma unroll
                for (int q = 0; q < 4; ++q) { const int row = 8 * r8 + 2 * q + (lane >> 5);
                    const float rs = rsq(((s4[q][0] + s4[q][1]) + (s4[q][2] + s4[q][3])) * (1.0f / 256.0f) + EPS); u32x4 v = mv[q];
#pragma unroll
                    for (int e = 0; e < 4; ++e) v[e] = pk2(bf_lo(v[e]) * rs, bf_hi(v[e]) * rs);
                    *(u32x4*)(mixed + (size_t)row * DM + 256 + 8 * (lane & 31)) = v; }
            }
        } else
#if PH_MASK & 16
        if (sub == 4) {
            pg8::Gemm g{(const bf16_t*)(ws + OFF_MIX), (const bf16_t*)(ws + OFF_WOUT + l * SZ_WOUT), M_TOK, DM, DM};
            S.init(M_TOK, DM, gridDim.x, blockIdx.x);
            pg8::EpiResidual E{(bf16_t*)(ws + OFF_HB), (float*)(ws + OFF_SSQF)};
            pg8::gemm_phase(lds, g, S, E);
        } else
#endif
#if PH_MASK & 32
        if (sub == 5) {
            pg8::Gemm g{(const bf16_t*)(ws + OFF_HB), (const bf16_t*)(ws + OFF_W1 + l * SZ_W1), M_TOK, DFF, DM};
            S.init(M_TOK, DFF, gridDim.x, blockIdx.x);
            LAS float* rstab = (LAS float*)(lds + pg8::STAGE_BYTES);
            pg8::build_rs_table(rstab, S, (const float*)(ws + OFF_SSQF));
            pg8::EpiScaleBf16<1> E{(bf16_t*)(ws + OFF_FB), DFF, rstab};
            pg8::gemm_phase(lds, g, S, E);
        } else
#endif
#if PH_MASK & 64
        if (sub == 6) {
            pg8::Gemm g{(const bf16_t*)(ws + OFF_FB), (const bf16_t*)(ws + OFF_W2 + l * SZ_W2), M_TOK, DM, DFF};
            S.init(M_TOK, DM, gridDim.x, blockIdx.x);
            pg8::EpiResidual E{(bf16_t*)(ws + OFF_HB), (float*)(ws + OFF_SSQA)};
            pg8::gemm_phase(lds, g, S, E);
        }
#endif
        {}
    }
}

#ifndef N_LAUNCH_MODE
#define N_LAUNCH_MODE 0
#endif

extern "C" void kernel_launch(void* const* d_in, const int* in_sizes, int n_in, void* d_out, int out_size, void* d_ws, size_t ws_size, hipStream_t stream) {
    static int grid = 0;
    if (grid == 0) {
        if (n_in != 24 || ws_size < WS_TOTAL) { fprintf(stderr, "kernel_launch: unexpected n_in %d / ws_size %zu (need %zu)\n", n_in, ws_size, (size_t)WS_TOTAL); grid = -1; return; }
        int dev = 0, cus = 0, per_cu = 0;
        hipGetDevice(&dev); hipDeviceGetAttribute(&cus, hipDeviceAttributeMultiprocessorCount, dev);
        if (hipFuncSetAttribute((const void*)fwd_kernel, hipFuncAttributeMaxDynamicSharedMemorySize, LDS_BYTES) != hipSuccess) { fprintf(stderr, "kernel_launch: hipFuncSetAttribute failed\n"); grid = -1; return; }
        if (hipOccupancyMaxActiveBlocksPerMultiprocessor(&per_cu, (const void*)fwd_kernel, 512, LDS_BYTES) != hipSuccess || per_cu < 1) { fprintf(stderr, "kernel_launch: occupancy query says %d\n", per_cu); per_cu = 1; }
        (void)hipGetLastError();
        grid = cus * 1;
    }
    if (grid < 0) return;
    Params p{};
    p.x = (const float*)d_in[0]; p.positions = (const int*)d_in[1]; p.mix_norm_g = (const float*)d_in[2]; p.w_in = (const float*)d_in[3]; p.conv_dw_w = (const float*)d_in[4];
    p.conv_dw_b = (const float*)d_in[5]; p.conv_ln_g = (const float*)d_in[6]; p.conv_ln_b = (const float*)d_in[7]; p.conv_pw_w = (const float*)d_in[8]; p.mla_q_norm_g = (const float*)d_in[9];
    p.mla_w_uq = (const float*)d_in[10]; p.mla_kv_norm_g = (const float*)d_in[11]; p.mla_w_ukv = (const float*)d_in[12]; p.pool_w = (const float*)d_in[13]; p.pool_scale = (const float*)d_in[14];
    p.gmlp_norm_g = (const float*)d_in[15]; p.gmlp_ws = (const float*)d_in[16]; p.gmlp_bs = (const float*)d_in[17]; p.group_norm_g = (const float*)d_in[18]; p.w_out = (const float*)d_in[19];
    p.ffn_norm_g = (const float*)d_in[20]; p.w_ff1 = (const float*)d_in[21]; p.w_ff2 = (const float*)d_in[22]; p.final_norm_g = (const float*)d_in[23];
    p.out = (float*)d_out; p.ws = (unsigned char*)d_ws;
    constexpr int NPH = 2 + 7 * DEPTH;
#if N_LAUNCH_MODE == 0
    p.ph_lo = 0; p.ph_hi = NPH;
    (void)hipMemsetAsync((unsigned char*)d_ws + OFF_BAR, 0, 512, stream);
    void* args[] = {&p};
    hipError_t e = hipLaunchCooperativeKernel((const void*)fwd_kernel, dim3(grid), dim3(512), args, LDS_BYTES, stream);
    if (e != hipSuccess) fprintf(stderr, "cooperative launch failed: %s (grid %d)\n", hipGetErrorString(e), grid);
#else
    for (int ph = 0; ph < NPH; ++ph) { p.ph_lo = ph; p.ph_hi = ph + 1; hipLaunchKernelGGL(fwd_kernel, dim3(grid), dim3(512), LDS_BYTES, stream, p); }
#endif
}
```

```cpp
#include <hip/hip_runtime.h>
#include <hip/hip_cooperative_groups.h>
#include <cstdio>
namespace cg = cooperative_groups;
#ifndef DUP_MASK
#define DUP_MASK 0
#endif
#ifndef MIX_MASK
#define MIX_MASK 15
#endif
#ifndef PH_MASK
#define PH_MASK 127
#endif

#define LAS __attribute__((address_space(3)))
typedef unsigned short bf16_t;
typedef short bf16x8 __attribute__((ext_vector_type(8)));
typedef short bf16x4 __attribute__((ext_vector_type(4)));
typedef float f32x4 __attribute__((ext_vector_type(4)));
typedef float f32x2 __attribute__((ext_vector_type(2)));
typedef float f32x16 __attribute__((ext_vector_type(16)));
typedef unsigned u32x4 __attribute__((ext_vector_type(4)));
typedef unsigned u32x2 __attribute__((ext_vector_type(2)));

constexpr int M_TOK = 32768, DM = 1024, SEQ = 4096, DEPTH = 4;
constexpr int DIN = 1632, DIN_P = 1792, DFF = 4096;
constexpr int ZC_G = 256, ZC_CQ = 512, ZC_CKV = 704, ZC_KR = 832, ZC_POOL = 864, ZC_U = 1120, ZC_V = 1376;
constexpr float EPS = 1e-6f;
constexpr float QSCALE = 0.14724444602590306f;

__constant__ float INV_FREQ[16] = {1.000000000e+00f, 5.623413324e-01f, 3.162277639e-01f, 1.778279394e-01f, 1.000000015e-01f, 5.623413250e-02f, 3.162277490e-02f, 1.778279431e-02f,
                                   9.999999776e-03f, 5.623413250e-03f, 3.162277630e-03f, 1.778279431e-03f, 1.000000047e-03f, 5.623413017e-04f, 3.162277571e-04f, 1.778279402e-04f};

constexpr size_t SZ_WIN = (size_t)DIN_P * DM * 2, SZ_WOUT = (size_t)DM * DM * 2, SZ_W1 = (size_t)DFF * DM * 2, SZ_W2 = SZ_W1;
constexpr size_t SZ_PW = 256 * 256 * 2, SZ_UQ = 384 * 192 * 2, SZ_UKV = 512 * 128 * 2, SZ_POOL = 4 * 64 * 64 * 2, SZ_GWS = 4 * 128 * 128 * 2;
constexpr size_t OFF_WIN = 0;
constexpr size_t OFF_WOUT = OFF_WIN + DEPTH * SZ_WIN;
constexpr size_t OFF_W1 = OFF_WOUT + DEPTH * SZ_WOUT;
constexpr size_t OFF_W2 = OFF_W1 + DEPTH * SZ_W1;
constexpr size_t OFF_PW = OFF_W2 + DEPTH * SZ_W2;
constexpr size_t OFF_UQ = OFF_PW + DEPTH * SZ_PW;
constexpr size_t OFF_UKV = OFF_UQ + DEPTH * SZ_UQ;
constexpr size_t OFF_POOL = OFF_UKV + DEPTH * SZ_UKV;
constexpr size_t OFF_GWS = OFF_POOL + DEPTH * SZ_POOL;
constexpr size_t OFF_HB = OFF_GWS + DEPTH * SZ_GWS;
constexpr size_t OFF_SSQA = OFF_HB + (size_t)M_TOK * DM * 2;
constexpr size_t OFF_SSQF = OFF_SSQA + (size_t)M_TOK * 16 * 4;
constexpr size_t OFF_SSQM = OFF_SSQF + (size_t)M_TOK * 16 * 4;
constexpr size_t OFF_ROPE = OFF_SSQM + (size_t)M_TOK * 4 * 4;
constexpr size_t OFF_UNION = OFF_ROPE + (size_t)M_TOK * 32 * 4;
constexpr size_t OFF_ZB = OFF_UNION;
constexpr size_t OFF_MIX = OFF_ZB + (size_t)M_TOK * DIN_P * 2;
constexpr size_t OFF_Q = OFF_MIX + (size_t)M_TOK * DM * 2;
constexpr size_t OFF_K = OFF_Q + (size_t)M_TOK * 384 * 2;
constexpr size_t OFF_VT = OFF_K + (size_t)M_TOK * 384 * 2;
constexpr size_t OFF_FB = OFF_UNION;
constexpr size_t WS_END = OFF_UNION + (size_t)M_TOK * DFF * 2;
constexpr size_t OFF_BAR = WS_END;
constexpr size_t WS_TOTAL = WS_END + 16384;
static_assert(OFF_VT + (size_t)M_TOK * 256 * 2 <= WS_END, "union overflow");
static_assert(OFF_HB % 256 == 0 && OFF_UNION % 256 == 0, "align");

constexpr int LDS_BYTES = 163840;

struct Params;
typedef const __attribute__((address_space(4))) Params* KP;
struct Params {
    const float* x; const int* positions; const float* mix_norm_g; const float* w_in; const float* conv_dw_w; const float* conv_dw_b; const float* conv_ln_g; const float* conv_ln_b;
    const float* conv_pw_w; const float* mla_q_norm_g; const float* mla_w_uq; const float* mla_kv_norm_g; const float* mla_w_ukv; const float* pool_w; const float* pool_scale;
    const float* gmlp_norm_g; const float* gmlp_ws; const float* gmlp_bs; const float* group_norm_g; const float* w_out; const float* ffn_norm_g; const float* w_ff1; const float* w_ff2;
    const float* final_norm_g;
    float* out; unsigned char* ws;
    int ph_lo, ph_hi;
};

__device__ __forceinline__ unsigned pk2(float lo, float hi) { unsigned r; asm("v_cvt_pk_bf16_f32 %0, %1, %2" : "=v"(r) : "v"(lo), "v"(hi)); return r; }
__device__ __forceinline__ float bf_lo(unsigned w) { return __uint_as_float(w << 16); }
__device__ __forceinline__ float bf_hi(unsigned w) { return __uint_as_float(w & 0xffff0000u); }
__device__ __forceinline__ float wave_sum(float v) {
#pragma unroll
    for (int o = 1; o < 64; o <<= 1) v += __shfl_xor(v, o);
    return v;
}
__device__ __forceinline__ f32x4 mfma16(bf16x8 a, bf16x8 b, f32x4 c) { return __builtin_amdgcn_mfma_f32_16x16x32_bf16(a, b, c, 0, 0, 0); }
__device__ __forceinline__ f32x16 mfma32(bf16x8 a, bf16x8 b, f32x16 c) { return __builtin_amdgcn_mfma_f32_32x32x16_bf16(a, b, c, 0, 0, 0); }
__device__ __forceinline__ float fast_rcp(float x) { return __builtin_amdgcn_rcpf(x); }
__device__ __forceinline__ float fast_exp2(float x) { return __builtin_amdgcn_exp2f(x); }
__device__ __forceinline__ float sigmoidf_(float x) { return fast_rcp(1.0f + fast_exp2(-1.4426950408889634f * x)); }
__device__ __forceinline__ float sumsq8(u32x4 v) {
    float s = 0.f;
#pragma unroll
    for (int i = 0; i < 4; ++i) { const float a = bf_lo(v[i]), b = bf_hi(v[i]); s += a * a + b * b; }
    return s;
}
__device__ __forceinline__ bf16x8 as_bf16x8(u32x4 v) { return __builtin_bit_cast(bf16x8, v); }

template <int N> __device__ __forceinline__ void pin(u32x4 (&b)[N]) {
    static_assert(N == 2 || N == 4 || N == 5 || N == 6 || N == 8 || N == 16, "pin size");
    if constexpr (N == 2) asm volatile("" : "+v"(b[0]), "+v"(b[1]));
    else if constexpr (N == 4) asm volatile("" : "+v"(b[0]), "+v"(b[1]), "+v"(b[2]), "+v"(b[3]));
    else if constexpr (N == 5) asm volatile("" : "+v"(b[0]), "+v"(b[1]), "+v"(b[2]), "+v"(b[3]), "+v"(b[4]));
    else if constexpr (N == 6) asm volatile("" : "+v"(b[0]), "+v"(b[1]), "+v"(b[2]), "+v"(b[3]), "+v"(b[4]), "+v"(b[5]));
    else if constexpr (N == 8) asm volatile("" : "+v"(b[0]), "+v"(b[1]), "+v"(b[2]), "+v"(b[3]), "+v"(b[4]), "+v"(b[5]), "+v"(b[6]), "+v"(b[7]));
    else asm volatile("" : "+v"(b[0]), "+v"(b[1]), "+v"(b[2]), "+v"(b[3]), "+v"(b[4]), "+v"(b[5]), "+v"(b[6]), "+v"(b[7]), "+v"(b[8]), "+v"(b[9]), "+v"(b[10]), "+v"(b[11]), "+v"(b[12]), "+v"(b[13]), "+v"(b[14]), "+v"(b[15]));
}
template <int N> __device__ __forceinline__ void ldfr(u32x4 (&b)[N], const bf16_t* ptr) {
#pragma unroll
    for (int ks = 0; ks < N; ++ks) b[ks] = *(const u32x4*)(ptr + 32 * ks);
}
__device__ __forceinline__ float rsq(float x) { return __builtin_amdgcn_rsqf(x); }


namespace pg8 {
constexpr int BM = 256, BK = 64, HALF = 128, HTB = HALF * BK * 2, STAGE_BYTES = 8 * HTB, NXCD = 8, WGM = 8;
__host__ __device__ __forceinline__ int lds_byte(int r, int c) { const int st = (r >> 4) * 2 + (c >> 5), rr = r & 15, cc = c & 31, ob = rr * 64 + cc * 2; return st * 1024 + (ob ^ (((ob >> 9) & 1) << 5)); }
__host__ __device__ __forceinline__ void stage_rc(int b, int& R, int& C) { const int st = b / 1024, sb = b % 1024, swz = sb ^ (((sb >> 9) & 1) << 5); R = (st >> 1) * 16 + swz / 64; C = (st & 1) * 32 + (swz % 64) / 2; }
__host__ __device__ __forceinline__ int perm32(int rho) { const int n = rho >> 4, i = rho & 15; return 8 * (i >> 2) + 4 * n + (i & 3); }
struct Unit { int pm, pn; };
struct Gemm { const bf16_t* A; const bf16_t* Bt; int M, N, K; };
struct StaticOrder {
    int nM, nN, nwg, G, c;
    __host__ __device__ void init(int M, int N, int G_, int c_) { nM = M / BM; nN = N / BM; nwg = nM * nN; G = G_; c = c_; }
    __host__ __device__ bool next(int i, Unit& u) const {
        const long L = (long)i * G + c; if (L >= nwg) return false;
        int wgid = (int)L; { const int q = nwg / NXCD, r = nwg % NXCD, xcd = wgid % NXCD, off = wgid / NXCD; wgid = (xcd < r ? xcd * (q + 1) : r * (q + 1) + (xcd - r) * q) + off; }
        const int nig = WGM * nN, gid = wgid / nig, fm = gid * WGM, gsz = (nM - fm) < WGM ? (nM - fm) : WGM;
        u.pm = fm + ((wgid % nig) % gsz); u.pn = (wgid % nig) / gsz; return true;
    }
};

__device__ __forceinline__ float row_rs(const float* ssq, int row) {
    const f32x4* p = (const f32x4*)(ssq + (size_t)row * 16);
    const f32x4 a = p[0], b = p[1], c = p[2], d = p[3];
    const float s = ((a[0] + a[1]) + (a[2] + a[3])) + ((b[0] + b[1]) + (b[2] + b[3])) + ((c[0] + c[1]) + (c[2] + c[3])) + ((d[0] + d[1]) + (d[2] + d[3]));
    return 1.0f / sqrtf(s * (1.0f / DM) + EPS);
}
template <int ACT  > struct EpiScaleBf16 {
    static constexpr bool PERM = true;
    bf16_t* O; int ldc; const LAS float* rstab;
    __device__ __forceinline__ void operator()(const f32x4 (&acc)[2][2][4][2], const Unit& u, int ui, int wr, int wc, int fr, int fq) const {
        const int lrow0 = wr * 64 + fr, row0 = u.pm * BM + lrow0, col0 = u.pn * BM + wc * 32 + 8 * fq;
        float rsv[2][4];
#pragma unroll
        for (int ai = 0; ai < 2; ++ai)
#pragma unroll
            for (int m = 0; m < 4; ++m) rsv[ai][m] = rstab[ui * 256 + lrow0 + ai * HALF + m * 16];
#pragma unroll
        for (int ai = 0; ai < 2; ++ai)
#pragma unroll
            for (int m = 0; m < 4; ++m) {
                const int row = row0 + ai * HALF + m * 16; const float rs = rsv[ai][m];
                bf16_t* rowp = O + (size_t)row * ldc + col0;
#pragma unroll
                for (int bj = 0; bj < 2; ++bj) {
                    f32x4 v0 = acc[ai][bj][m][0] * rs, v1 = acc[ai][bj][m][1] * rs;
                    if (ACT == 1) {
#pragma unroll
                        for (int j = 0; j < 4; ++j) { const float a = fmaxf(v0[j], 0.f), b = fmaxf(v1[j], 0.f); v0[j] = a * a; v1[j] = b * b; }
                    }
                    u32x4 w; w.x = pk2(v0[0], v0[1]); w.y = pk2(v0[2], v0[3]); w.z = pk2(v1[0], v1[1]); w.w = pk2(v1[2], v1[3]);
                    *(u32x4*)(rowp + bj * HALF) = w;
                }
            }
    }
};
__device__ __forceinline__ void build_rs_table(LAS float* rstab, const StaticOrder& S, const float* ssq) {
    int tid = threadIdx.x; asm volatile("" : "+v"(tid));
    Unit u;
#pragma unroll 1
    for (int i0 = 0; i0 < 16; i0 += 8) {
        f32x4 pv[4][4]; bool ok[4];
#pragma unroll
        for (int q = 0; q < 4; ++q) { const int i = i0 + 2 * q + (tid >> 8); ok[q] = S.next(i, u);
            const f32x4* pp = (const f32x4*)(ssq + (size_t)((ok[q] ? u.pm : 0) * BM + (tid & 255)) * 16);
#pragma unroll
            for (int j = 0; j < 4; ++j) pv[q][j] = pp[j]; }
#pragma unroll
        for (int q = 0; q < 4; ++q) { const int i = i0 + 2 * q + (tid >> 8);
            const f32x4 a = pv[q][0], b = pv[q][1], c = pv[q][2], d = pv[q][3];
            const float sm = ((a[0] + a[1]) + (a[2] + a[3])) + ((b[0] + b[1]) + (b[2] + b[3])) + ((c[0] + c[1]) + (c[2] + c[3])) + ((d[0] + d[1]) + (d[2] + d[3]));
            if (ok[q]) rstab[i * 256 + (tid & 255)] = 1.0f / sqrtf(sm * (1.0f / DM) + EPS); }
    }
    __syncthreads();
}
struct EpiResidual {
    static constexpr bool PERM = true;
    bf16_t* hb; float* ssq;
    __device__ __forceinline__ void operator()(const f32x4 (&acc)[2][2][4][2], const Unit& u, int  , int wr, int wc, int fr, int fq) const {
        const int row0 = u.pm * BM + wr * 64 + fr, col0 = u.pn * BM + wc * 32 + 8 * fq;
        u32x4 rv[2][2];
#pragma unroll
        for (int bj = 0; bj < 2; ++bj) rv[0][bj] = *(const u32x4*)(hb + (size_t)row0 * DM + col0 + bj * HALF);
#pragma unroll
        for (int g = 0; g < 8; ++g) {
            const int ai = g >> 2, m = g & 3;
            const int row = row0 + ai * HALF + m * 16; const size_t off = (size_t)row * DM + col0; float s = 0.f;
            if (g < 7) { const int g1 = g + 1; const size_t off1 = (size_t)(row0 + (g1 >> 2) * HALF + (g1 & 3) * 16) * DM + col0;
#pragma unroll
                for (int bj = 0; bj < 2; ++bj) rv[g1 & 1][bj] = *(const u32x4*)(hb + off1 + bj * HALF); }
#pragma unroll
            for (int bj = 0; bj < 2; ++bj) {
                const u32x4 r = rv[g & 1][bj]; const f32x4 a0 = acc[ai][bj][m][0], a1 = acc[ai][bj][m][1];
                u32x4 o; o.x = pk2(bf_lo(r.x) + a0[0], bf_hi(r.x) + a0[1]); o.y = pk2(bf_lo(r.y) + a0[2], bf_hi(r.y) + a0[3]);
                o.z = pk2(bf_lo(r.z) + a1[0], bf_hi(r.z) + a1[1]); o.w = pk2(bf_lo(r.w) + a1[2], bf_hi(r.w) + a1[3]);
                *(u32x4*)(hb + off + bj * HALF) = o;
#pragma unroll
                for (int e = 0; e < 4; ++e) { const float x0 = bf_lo(o[e]), x1 = bf_hi(o[e]); s += x0 * x0 + x1 * x1; }
            }
            s += __shfl_xor(s, 16); s += __shfl_xor(s, 32);
            if (fq == 0) ssq[(size_t)row * 16 + u.pn * 4 + wc] = s;
        }
    }
};

template <class Epi>
__device__ __forceinline__ void gemm_phase(LAS unsigned char* lds, const Gemm g, const StaticOrder& S, const Epi& E) {
    int tid = threadIdx.x; asm volatile("" : "+v"(tid));
    const int wid = __builtin_amdgcn_readfirstlane(tid >> 6), lane = tid & 63, wr = wid >> 2, wc = wid & 3, fr = lane & 15, fq = lane >> 4;
    const int K = g.K, nt = K / BK;
    unsigned voffA[2], voffB[2];
#pragma unroll
    for (int i = 0; i < 2; ++i) { int R, C; stage_rc(tid * 16 + i * 8192, R, C); const int Rb = Epi::PERM ? ((R & ~31) + perm32(R & 31)) : R;
        voffA[i] = (unsigned)(R * K + C) * 2u; voffB[i] = (unsigned)(Rb * K + C) * 2u; }
    const size_t kstep = (size_t)(BK * 2);
    const size_t hstep = (size_t)HALF * K * 2;
    const size_t tstep = 2 * hstep;
    const unsigned ldsw = (unsigned)wid * 1024u;
    const int aoff = lds_byte(wr * 64 + fr, fq * 8), boff = lds_byte(wc * 32 + fr, fq * 8);
#define PG8_SA(b, h) (((b) * 2 + (h)) * HTB)
#define PG8_SB(b, h) ((4 + (b) * 2 + (h)) * HTB)
#define PG8_STAGE(bufoff, gbase, voff) do { _Pragma("unroll") for (int _i = 0; _i < 2; ++_i) \
        __builtin_amdgcn_global_load_lds((const unsigned*)((const char*)(gbase) + (voff)[_i]), (LAS unsigned*)(lds + (bufoff) + ldsw + _i * 8192), 16, 0, 0); } while (0)
#define PG8_LDA(dst, b, h) do { _Pragma("unroll") for (int m = 0; m < 4; ++m) _Pragma("unroll") for (int k = 0; k < 2; ++k) dst[m][k] = *(const LAS bf16x8*)(lds + PG8_SA(b, h) + aoff + m * 2048 + k * 1024); } while (0)
#define PG8_LDB(dst, b, h) do { _Pragma("unroll") for (int n = 0; n < 2; ++n) _Pragma("unroll") for (int k = 0; k < 2; ++k) dst[n][k] = *(const LAS bf16x8*)(lds + PG8_SB(b, h) + boff + n * 2048 + k * 1024); } while (0)
#define PG8_MMA(ai, bj, At, Bt) do { __builtin_amdgcn_s_setprio(1); _Pragma("unroll") for (int m = 0; m < 4; ++m) _Pragma("unroll") for (int n = 0; n < 2; ++n) _Pragma("unroll") for (int k = 0; k < 2; ++k) \
        acc[ai][bj][m][n] = __builtin_amdgcn_mfma_f32_16x16x32_bf16(Bt[n][k], At[m][k], acc[ai][bj][m][n], 0, 0, 0); __builtin_amdgcn_s_setprio(0); } while (0)
#define PG8_WAIT_V(n) asm volatile("s_waitcnt vmcnt(" #n ")" ::: "memory")
#define PG8_WAIT_L(n) asm volatile("s_waitcnt lgkmcnt(" #n ")" ::: "memory")
#define PG8_BAR __builtin_amdgcn_s_barrier()
#define PG8_SCHED __builtin_amdgcn_sched_barrier(0)
    Unit cur, nxt; int ui = 0;
    if (!S.next(0, cur)) return;
    f32x4 acc[2][2][4][2];
#pragma unroll
    for (int a = 0; a < 2; ++a)
#pragma unroll
        for (int b = 0; b < 2; ++b)
#pragma unroll
            for (int m = 0; m < 4; ++m)
#pragma unroll
                for (int n = 0; n < 2; ++n) acc[a][b][m][n] = (f32x4){0.f, 0.f, 0.f, 0.f};
    bf16x8 At[4][2], B0[2][2], B1[2][2];
    const char* cA = (const char*)g.A + (size_t)cur.pm * tstep; const char* cB = (const char*)g.Bt + (size_t)cur.pn * tstep;
    PG8_STAGE(PG8_SB(0, 0), cB, voffB); PG8_STAGE(PG8_SA(0, 0), cA, voffA); PG8_STAGE(PG8_SB(0, 1), cB + hstep, voffB); PG8_STAGE(PG8_SA(0, 1), cA + hstep, voffA);
    if (wr == 1) PG8_BAR;
    PG8_WAIT_V(4); PG8_BAR;
    PG8_STAGE(PG8_SB(1, 0), cB + kstep, voffB); PG8_STAGE(PG8_SA(1, 0), cA + kstep, voffA); PG8_STAGE(PG8_SB(1, 1), cB + hstep + kstep, voffB);
    PG8_WAIT_V(6); PG8_BAR;
    for (;;) {
        const bool has_next = S.next(ui + 1, nxt);
        const char* nA = has_next ? (const char*)g.A + (size_t)nxt.pm * tstep : cA; const char* nB = has_next ? (const char*)g.Bt + (size_t)nxt.pn * tstep : cB;
        for (int t = 0; t < nt; t += 2) {
            const bool last = (t == nt - 2);
            const char* a1 = cA + (size_t)(t + 1) * kstep;
            const char* a2 = last ? nA : cA + (size_t)(t + 2) * kstep; const char* b2 = last ? nB : cB + (size_t)(t + 2) * kstep;
            const char* a3 = a2 + kstep; const char* b3 = b2 + kstep;
            PG8_LDB(B0, 0, 0); PG8_SCHED; PG8_LDA(At, 0, 0); PG8_STAGE(PG8_SA(1, 1), a1 + hstep, voffA);
            PG8_WAIT_L(8); PG8_BAR; PG8_WAIT_L(0); PG8_MMA(0, 0, At, B0); PG8_BAR; PG8_SCHED;
            PG8_LDB(B1, 0, 1); PG8_STAGE(PG8_SB(0, 0), b2, voffB);
            PG8_BAR; PG8_WAIT_L(0); PG8_MMA(0, 1, At, B1); PG8_BAR;
            PG8_LDA(At, 0, 1); PG8_STAGE(PG8_SA(0, 0), a2, voffA);
            PG8_BAR; PG8_WAIT_L(0); PG8_MMA(1, 0, At, B0); PG8_BAR; PG8_SCHED;
            PG8_STAGE(PG8_SB(0, 1), b2 + hstep, voffB);
            PG8_WAIT_V(6); PG8_BAR; PG8_MMA(1, 1, At, B1); PG8_BAR;
            PG8_LDB(B0, 1, 0); PG8_SCHED; PG8_LDA(At, 1, 0); PG8_STAGE(PG8_SA(0, 1), a2 + hstep, voffA);
            PG8_WAIT_L(8); PG8_BAR; PG8_WAIT_L(0); PG8_MMA(0, 0, At, B0); PG8_BAR; PG8_SCHED;
            PG8_LDB(B1, 1, 1); PG8_STAGE(PG8_SB(1, 0), b3, voffB);
            PG8_BAR; PG8_WAIT_L(0); PG8_MMA(0, 1, At, B1); PG8_BAR;
            PG8_LDA(At, 1, 1); PG8_STAGE(PG8_SA(1, 0), a3, voffA);
            PG8_BAR; PG8_WAIT_L(0); PG8_MMA(1, 0, At, B0); PG8_BAR; PG8_SCHED;
            PG8_STAGE(PG8_SB(1, 1), b3 + hstep, voffB);
            PG8_WAIT_V(6); PG8_BAR; PG8_MMA(1, 1, At, B1); PG8_BAR;
        }
        E(acc, cur, ui, wr, wc, fr, fq);
        if (!has_next) break;
#pragma unroll
        for (int a = 0; a < 2; ++a)
#pragma unroll
            for (int b = 0; b < 2; ++b)
#pragma unroll
                for (int m = 0; m < 4; ++m)
#pragma unroll
                    for (int n = 0; n < 2; ++n) acc[a][b][m][n] = (f32x4){0.f, 0.f, 0.f, 0.f};
        cur = nxt; cA = nA; cB = nB; ++ui;
    }
    PG8_WAIT_V(0);
    if (wr == 0) PG8_BAR;
    PG8_BAR;
#undef PG8_SA
#undef PG8_SB
#undef PG8_STAGE
#undef PG8_LDA
#undef PG8_LDB
#undef PG8_MMA
#undef PG8_WAIT_V
#undef PG8_WAIT_L
#undef PG8_BAR
#undef PG8_SCHED
}
}

__device__ __forceinline__ void pinf8(float (&v)[32], int o) {
    asm volatile("" : "+v"(v[o]), "+v"(v[o + 1]), "+v"(v[o + 2]), "+v"(v[o + 3]), "+v"(v[o + 4]), "+v"(v[o + 5]), "+v"(v[o + 6]), "+v"(v[o + 7]));
}
__device__ __forceinline__ void transpose_item(const float* W, int N, const float* kscale, const float* nscale, bf16_t* WT, int ldk, LAS float* scr, int item, int lane) {
    const int nblk = N / 32, kb = item / nblk, nb = item % nblk, k0 = 64 * kb, n0 = 32 * nb;
    const int c = lane & 7;
    float v[32];
    const float* src = W + (size_t)(k0 + (lane >> 5)) * N + n0 + (lane & 31);
#pragma unroll
    for (int i = 0; i < 32; ++i) v[i] = src[(size_t)(2 * i) * N];
    f32x4 ks0 = (f32x4){1.f, 1.f, 1.f, 1.f}, ks1 = ks0;
    if (kscale) { ks0 = *(const f32x4*)(kscale + k0 + 8 * c); ks1 = *(const f32x4*)(kscale + k0 + 8 * c + 4); }
    float nsv[4];
#pragma unroll
    for (int j = 0; j < 4; ++j) nsv[j] = nscale ? nscale[n0 + (lane >> 3) + 8 * j] : 1.0f;
    pinf8(v, 0); pinf8(v, 8); pinf8(v, 16); pinf8(v, 24);
#pragma unroll
    for (int i = 0; i < 32; ++i) scr[(2 * i + (lane >> 5)) * 33 + (lane & 31)] = v[i];
    asm volatile("s_waitcnt lgkmcnt(0)" ::: "memory");
#pragma unroll
    for (int j = 0; j < 4; ++j) { const int n = (lane >> 3) + 8 * j; const LAS float* s = scr + (8 * c) * 33 + n; const float ns = nsv[j];
        u32x4 o; o.x = pk2(s[0 * 33] * ks0[0] * ns, s[1 * 33] * ks0[1] * ns); o.y = pk2(s[2 * 33] * ks0[2] * ns, s[3 * 33] * ks0[3] * ns);
        o.z = pk2(s[4 * 33] * ks1[0] * ns, s[5 * 33] * ks1[1] * ns); o.w = pk2(s[6 * 33] * ks1[2] * ns, s[7 * 33] * ks1[3] * ns);
        *(u32x4*)(WT + (size_t)(n0 + n) * ldk + k0 + 8 * c) = o; }
    asm volatile("s_waitcnt lgkmcnt(0)" ::: "memory");
}

__device__ __forceinline__ void phase_prologue(KP p, LAS unsigned char* lds) {
    int tid = threadIdx.x; asm volatile("" : "+v"(tid));
    const int lane = tid & 63, wave = tid >> 6;
    const int gw = blockIdx.x * 8 + wave, NGW = gridDim.x * 8;
    LAS float* scr = (LAS float*)(lds + wave * 8448);
    unsigned char* ws = p->ws;
    constexpr int I_IN = 16 * 51, I_OUT = 16 * 32, I_FF1 = 16 * 128, I_FF2 = 64 * 32, I_PW = 4 * 8, I_UQ = 3 * 12, I_UKV = 2 * 16, I_POOL = 4 * 2;
    constexpr int I_LAYER = I_IN + I_OUT + I_FF1 + I_FF2 + I_PW + I_UQ + I_UKV + I_POOL;
    for (int it = gw; it < DEPTH * I_LAYER; it += NGW) {
        const int l = it / I_LAYER; int r = it % I_LAYER;
        if (r < I_IN) { transpose_item(p->w_in + (size_t)l * DM * DIN, DIN, p->mix_norm_g + l * DM, nullptr, (bf16_t*)(ws + OFF_WIN + l * SZ_WIN), DM, scr, r, lane); continue; } r -= I_IN;
        if (r < I_OUT) { transpose_item(p->w_out + (size_t)l * DM * DM, DM, p->group_norm_g + l * DM, nullptr, (bf16_t*)(ws + OFF_WOUT + l * SZ_WOUT), DM, scr, r, lane); continue; } r -= I_OUT;
        if (r < I_FF1) { transpose_item(p->w_ff1 + (size_t)l * DM * DFF, DFF, p->ffn_norm_g + l * DM, nullptr, (bf16_t*)(ws + OFF_W1 + l * SZ_W1), DM, scr, r, lane); continue; } r -= I_FF1;
        if (r < I_FF2) { transpose_item(p->w_ff2 + (size_t)l * DFF * DM, DM, nullptr, nullptr, (bf16_t*)(ws + OFF_W2 + l * SZ_W2), DFF, scr, r, lane); continue; } r -= I_FF2;
        if (r < I_PW) { transpose_item(p->conv_pw_w + (size_t)l * 256 * 256, 256, nullptr, nullptr, (bf16_t*)(ws + OFF_PW + l * SZ_PW), 256, scr, r, lane); continue; } r -= I_PW;
        if (r < I_UQ) { transpose_item(p->mla_w_uq + (size_t)l * 192 * 384, 384, p->mla_q_norm_g + l * 192, nullptr, (bf16_t*)(ws + OFF_UQ + l * SZ_UQ), 192, scr, r, lane); continue; } r -= I_UQ;
        if (r < I_UKV) { transpose_item(p->mla_w_ukv + (size_t)l * 128 * 512, 512, p->mla_kv_norm_g + l * 128, nullptr, (bf16_t*)(ws + OFF_UKV + l * SZ_UKV), 128, scr, r, lane); continue; } r -= I_UKV;
        { const int g = r >> 1, sub = r & 1;
          transpose_item(p->pool_w + (size_t)(l * 4 + g) * 64 * 64, 64, nullptr, p->pool_scale + l * 256 + g * 64, (bf16_t*)(ws + OFF_POOL + l * SZ_POOL) + g * 64 * 64, 64, scr, sub, lane); }
    }
    const int gt = blockIdx.x * 512 + tid, NGT = gridDim.x * 512;
    for (int i = gt; i < DEPTH * 160 * (DM / 8); i += NGT) { const int l = i / (160 * 128), r = i % (160 * 128);
        *(u32x4*)((bf16_t*)(ws + OFF_WIN + l * SZ_WIN) + (size_t)(DIN + r / 128) * DM + (r % 128) * 8) = (u32x4){0u, 0u, 0u, 0u}; }
    for (int i = gt; i < DEPTH * 4 * 128 * 128 / 2; i += NGT) { const int e = 2 * i, jj = e & 127, ii = (e >> 7) & 127; const f32x2 v = *(const f32x2*)(p->gmlp_ws + e);
        *(unsigned*)((bf16_t*)(ws + OFF_GWS) + e) = pk2(jj <= ii ? v[0] : 0.f, (jj + 1) <= ii ? v[1] : 0.f); }
    for (int i = gt; i < M_TOK * 16; i += NGT) { const int row = i >> 4, k = i & 15; const float ang = (float)p->positions[row] * INV_FREQ[k];
        const double a = (double)ang; const double n = rint(a * 0.15915494309189535); const float rr = (float)(a - n * 6.283185307179586);
        float* rt = (float*)(ws + OFF_ROPE) + (size_t)row * 32; rt[k] = cosf(rr); rt[16 + k] = sinf(rr); }
    for (int r4 = gw; r4 < M_TOK / 4; r4 += NGW) {
        u32x4 xv[16];
#pragma unroll
        for (int q = 0; q < 4; ++q)
#pragma unroll
            for (int j = 0; j < 4; ++j) xv[4 * q + j] = *((const u32x4*)(p->x + (size_t)(4 * r4 + q) * DM) + lane + 64 * j);
        pin(xv);
        float sv[4];
#pragma unroll
        for (int q = 0; q < 4; ++q) {
            u32x2* hr = (u32x2*)((bf16_t*)(ws + OFF_HB) + (size_t)(4 * r4 + q) * DM) + lane; float s = 0.f;
#pragma unroll
            for (int j = 0; j < 4; ++j) { const f32x4 v = __builtin_bit_cast(f32x4, xv[4 * q + j]); s += (v[0] * v[0] + v[1] * v[1]) + (v[2] * v[2] + v[3] * v[3]); u32x2 w2; w2.x = pk2(v[0], v[1]); w2.y = pk2(v[2], v[3]); hr[64 * j] = w2; }
            sv[q] = s;
        }
#pragma unroll
        for (int o = 1; o < 64; o <<= 1)
#pragma unroll
            for (int q = 0; q < 4; ++q) sv[q] += __shfl_xor(sv[q], o);
        const float mine = (lane >> 4) == 0 ? sv[0] : ((lane >> 4) == 1 ? sv[1] : ((lane >> 4) == 2 ? sv[2] : sv[3]));
        ((float*)(ws + OFF_SSQA))[(size_t)(4 * r4) * 16 + lane] = (lane & 15) == 0 ? mine : 0.f;
    }
}

constexpr int R1_BYTES = 88064, R2_OFF = R1_BYTES, R2_BYTES = 67584, R3_OFF = R2_OFF + R2_BYTES;
constexpr int YLD = 264, CQLD = 200, CKLD = 136, VLD = 136, CK_OFF = 128 * CQLD * 2, RS_OFF = CK_OFF + 128 * CKLD * 2;
static_assert(RS_OFF + 1024 <= R1_BYTES && R3_OFF + 8192 <= LDS_BYTES, "mixer LDS map");

template <int NKS, int NNT>
__device__ __forceinline__ void wgemm(f32x4 (&acc)[8][NNT], const LAS bf16_t* A, const int lda, const bf16_t* Bp, const int ldb) {
    u32x4 bf[NNT][NKS];
#pragma unroll
    for (int nt = 0; nt < NNT; ++nt) ldfr(bf[nt], Bp + (size_t)(16 * nt) * ldb);
#pragma unroll
    for (int nt = 0; nt < NNT; ++nt) pin(bf[nt]);
#pragma unroll
    for (int mt = 0; mt < 8; ++mt) {
        bf16x8 af[NKS];
#pragma unroll
        for (int ks = 0; ks < NKS; ++ks) af[ks] = *(const LAS bf16x8*)(A + (16 * mt) * lda + 32 * ks);
#pragma unroll
        for (int nt = 0; nt < NNT; ++nt) { f32x4 a = (f32x4){0.f, 0.f, 0.f, 0.f};
#pragma unroll
            for (int ks = 0; ks < NKS; ++ks) a = mfma16(as_bf16x8(bf[nt][ks]), af[ks], a);
            acc[mt][nt] = a; }
    }
}
template <int NNT>
__device__ __forceinline__ void part_sumsq(const f32x4 (&acc)[8][NNT], LAS float* part, int w, int fr, int fq) {
#pragma unroll
    for (int mt = 0; mt < 8; ++mt) { float s = 0.f;
#pragma unroll
        for (int nt = 0; nt < NNT; ++nt) s += (acc[mt][nt][0] * acc[mt][nt][0] + acc[mt][nt][1] * acc[mt][nt][1]) + (acc[mt][nt][2] * acc[mt][nt][2] + acc[mt][nt][3] * acc[mt][nt][3]);
        s += __shfl_xor(s, 16); s += __shfl_xor(s, 32);
        if (fq == 0) part[(16 * mt + fr) * 8 + w] = s; }
}
template <int NNT>
__device__ __forceinline__ void norm_store(const f32x4 (&acc)[8][NNT], const LAS float* part, bf16_t* dst, int fr) {
#pragma unroll
    for (int mt = 0; mt < 8; ++mt) {
        const LAS f32x4* pp = (const LAS f32x4*)(part + (16 * mt + fr) * 8); const f32x4 a = pp[0], b = pp[1];
        const float rs = rsq((((a[0] + a[1]) + (a[2] + a[3])) + ((b[0] + b[1]) + (b[2] + b[3]))) * (1.0f / 256.0f) + EPS);
#pragma unroll
        for (int nt = 0; nt < NNT; ++nt) { u32x2 o; o.x = pk2(acc[mt][nt][0] * rs, acc[mt][nt][1] * rs); o.y = pk2(acc[mt][nt][2] * rs, acc[mt][nt][3] * rs);
            *(u32x2*)(dst + (size_t)(16 * mt) * DM + 16 * nt) = o; }
    }
}

__device__ __forceinline__ void mixer_chunk(KP p, LAS unsigned char* lds, int l, int chunk) {
    int tid = threadIdx.x; asm volatile("" : "+v"(tid));
    const int lane = tid & 63, w = __builtin_amdgcn_readfirstlane(tid >> 6), fr = lane & 15, fq = lane >> 4;
    unsigned char* ws = p->ws;
    const bf16_t* zb = (const bf16_t*)(ws + OFF_ZB);
    bf16_t* mixed = (bf16_t*)(ws + OFF_MIX);
    const int c0 = chunk * 128, bidx = chunk >> 5, s0 = (chunk & 31) * 128;
    LAS bf16_t* Y = (LAS bf16_t*)lds; LAS bf16_t* CO = (LAS bf16_t*)(lds + R2_OFF); LAS bf16_t* VT = (LAS bf16_t*)lds;
    LAS bf16_t* CQ = (LAS bf16_t*)lds; LAS bf16_t* CK = (LAS bf16_t*)(lds + CK_OFF); LAS float* RSQ = (LAS float*)(lds + RS_OFF); LAS float* RSK = RSQ + 128;
    LAS bf16_t* ZP = (LAS bf16_t*)lds; LAS bf16_t* YP = (LAS bf16_t*)(lds + R2_OFF);
    LAS float* part0 = (LAS float*)(lds + R3_OFF); LAS float* part1 = part0 + 1024;
    bf16_t* mrow = mixed + (size_t)(c0 + fr) * DM + 4 * fq;

#pragma unroll 1
    for (int half = 0; half < 2; ++half) {
        u32x4 av[5], gv[5];
#pragma unroll
        for (int i = 0; i < 5; ++i) {
            const int q = tid + 512 * (5 * half + i); int r = q >> 5; r = r < 158 ? r : 157; const int cc = (q & 31) * 8;
            const int rr = (s0 - 30 + r >= 0) ? (c0 - 30 + r) : c0;
            const bf16_t* zq = zb + (size_t)rr * DIN_P + cc; av[i] = *(const u32x4*)zq; gv[i] = *(const u32x4*)(zq + ZC_G);
        }
        pin(av); pin(gv);
#pragma unroll
        for (int i = 0; i < 5; ++i) {
            const int q = tid + 512 * (5 * half + i); const int r = q >> 5, cc = (q & 31) * 8;
            u32x4 o;
#pragma unroll
            for (int e = 0; e < 4; ++e) o[e] = pk2(bf_lo(av[i][e]) * sigmoidf_(bf_lo(gv[i][e])), bf_hi(av[i][e]) * sigmoidf_(bf_hi(gv[i][e])));
            if (s0 - 30 + r < 0) o = (u32x4){0u, 0u, 0u, 0u};
            if (r < 158) *(LAS u32x4*)(Y + r * YLD + cc) = o;
        }
    }
    __syncthreads();
    {
        const int hc = w & 1, tq = w >> 1, c = 128 * hc + 2 * lane;
        const float* dw = p->conv_dw_w + (size_t)l * 31 * 256 + c;
        float w0[31], w1[31];
#pragma unroll
        for (int j = 0; j < 31; ++j) { const f32x2 ww = *(const f32x2*)(dw + j * 256); w0[j] = ww[0]; w1[j] = ww[1]; }
        const f32x2 bb = *(const f32x2*)(p->conv_dw_b + l * 256 + c);
#pragma unroll 1
        for (int blk = 0; blk < 4; ++blk) {
            const int t0 = 32 * tq + 8 * blk;
            float a0[8], a1[8];
#pragma unroll
            for (int o = 0; o < 8; ++o) { a0[o] = bb[0]; a1[o] = bb[1]; }
#pragma unroll
            for (int r = 0; r < 38; ++r) {
                const unsigned yv = *(const LAS unsigned*)(Y + (t0 + r) * YLD + c); const float y0 = bf_lo(yv), y1 = bf_hi(yv);
#pragma unroll
                for (int o = 0; o < 8; ++o) { const int j = r - o; if (j >= 0 && j <= 30) { a0[o] += w0[j] * y0; a1[o] += w1[j] * y1; } }
            }
#pragma unroll
            for (int o = 0; o < 8; ++o) *(LAS unsigned*)(CO + (t0 + o) * YLD + c) = pk2(a0[o], a1[o]);
        }
    }
    __syncthreads();
    u32x4 sq[6], sk[4];
#pragma unroll
    for (int i = 0; i < 6; ++i) { const int q = tid + 512 * i, r = q / 24, pc = q % 24; sq[i] = *(const u32x4*)(zb + (size_t)(c0 + r) * DIN_P + ZC_CQ + 8 * pc); }
#pragma unroll
    for (int i = 0; i < 4; ++i) { const int q = tid + 512 * i, r = q >> 4, pc = q & 15; sk[i] = *(const u32x4*)(zb + (size_t)(c0 + r) * DIN_P + ZC_CKV + 8 * pc); }
    {
        const f32x4 lg = *(const f32x4*)(p->conv_ln_g + l * 256 + 4 * lane), lb = *(const f32x4*)(p->conv_ln_b + l * 256 + 4 * lane);
#pragma unroll 1
        for (int half = 0; half < 2; ++half) {
            f32x4 x[8]; float s[8];
#pragma unroll
            for (int i = 0; i < 8; ++i) { const u32x2 v = *(const LAS u32x2*)(CO + (16 * w + 8 * half + i) * YLD + 4 * lane);
                x[i] = (f32x4){bf_lo(v.x), bf_hi(v.x), bf_lo(v.y), bf_hi(v.y)}; s[i] = (x[i][0] + x[i][1]) + (x[i][2] + x[i][3]); }
#pragma unroll
            for (int o = 1; o < 64; o <<= 1)
#pragma unroll
                for (int i = 0; i < 8; ++i) s[i] += __shfl_xor(s[i], o);
#pragma unroll
            for (int i = 0; i < 8; ++i) { x[i] = x[i] - s[i] * (1.0f / 256.0f); s[i] = (x[i][0] * x[i][0] + x[i][1] * x[i][1]) + (x[i][2] * x[i][2] + x[i][3] * x[i][3]); }
#pragma unroll
            for (int o = 1; o < 64; o <<= 1)
#pragma unroll
                for (int i = 0; i < 8; ++i) s[i] += __shfl_xor(s[i], o);
#pragma unroll
            for (int i = 0; i < 8; ++i) {
                const float rstd = rsq(s[i] * (1.0f / 256.0f) + EPS);
                f32x4 y = x[i] * rstd * lg + lb;
#pragma unroll
                for (int j = 0; j < 4; ++j) y[j] = y[j] * sigmoidf_(y[j]);
                u32x2 o; o.x = pk2(y[0], y[1]); o.y = pk2(y[2], y[3]); *(LAS u32x2*)(CO + (16 * w + 8 * half + i) * YLD + 4 * lane) = o;
            }
        }
    }
    pin(sq); pin(sk);
#pragma unroll
    for (int i = 0; i < 6; ++i) { const int q = tid + 512 * i, r = q / 24, pc = q % 24; *(LAS u32x4*)(CQ + r * CQLD + 8 * pc) = sq[i]; }
#pragma unroll
    for (int i = 0; i < 4; ++i) { const int q = tid + 512 * i, r = q >> 4, pc = q & 15; *(LAS u32x4*)(CK + r * CKLD + 8 * pc) = sk[i]; }
    __syncthreads();
    f32x4 accc[8][2];
    wgemm<8, 2>(accc, CO + fr * YLD + 8 * fq, YLD, (const bf16_t*)(ws + OFF_PW + l * SZ_PW) + (size_t)(32 * w + fr) * 256 + 8 * fq, 256);
    part_sumsq<2>(accc, part0, w, fr, fq);
    {
        float ssq_ = 0.f, ssk = 0.f;
#pragma unroll
        for (int ks = 0; ks < 6; ++ks) ssq_ += sumsq8(*(const LAS u32x4*)(CQ + (16 * w + fr) * CQLD + 32 * ks + 8 * fq));
#pragma unroll
        for (int ks = 0; ks < 4; ++ks) ssk += sumsq8(*(const LAS u32x4*)(CK + (16 * w + fr) * CKLD + 32 * ks + 8 * fq));
        ssq_ += __shfl_xor(ssq_, 16); ssq_ += __shfl_xor(ssq_, 32); ssk += __shfl_xor(ssk, 16); ssk += __shfl_xor(ssk, 32);
        if (fq == 0) { RSQ[16 * w + fr] = QSCALE * rsq(ssq_ * (1.0f / 192.0f) + EPS); RSK[16 * w + fr] = rsq(ssk * (1.0f / 128.0f) + EPS); }
        const int row = c0 + 16 * w + fr, spos = s0 + 16 * w + fr;
        const bf16_t* zr = zb + (size_t)row * DIN_P; const float* rt = (const float*)(ws + OFF_ROPE) + (size_t)row * 32;
        const u32x2 r1 = *(const u32x2*)(zr + ZC_KR + 4 * fq), r2 = *(const u32x2*)(zr + ZC_KR + 16 + 4 * fq);
        const f32x4 cs = *(const f32x4*)(rt + 4 * fq), sn = *(const f32x4*)(rt + 16 + 4 * fq);
        const f32x4 k1 = (f32x4){bf_lo(r1.x), bf_hi(r1.x), bf_lo(r1.y), bf_hi(r1.y)}, k2 = (f32x4){bf_lo(r2.x), bf_hi(r2.x), bf_lo(r2.y), bf_hi(r2.y)};
        const f32x4 o1 = k1 * cs - k2 * sn, o2 = k2 * cs + k1 * sn;
        u32x2 ro1, ro2; ro1.x = pk2(o1[0], o1[1]); ro1.y = pk2(o1[2], o1[3]); ro2.x = pk2(o2[0], o2[1]); ro2.y = pk2(o2[2], o2[3]);
        bf16_t* kd = (bf16_t*)(ws + OFF_K) + ((size_t)(bidx * 4) * SEQ + spos) * 96 + 64 + 4 * fq;
#pragma unroll
        for (int h = 0; h < 4; ++h) { *(u32x2*)(kd + (size_t)h * SEQ * 96) = ro1; *(u32x2*)(kd + (size_t)h * SEQ * 96 + 16) = ro2; }
    }
    __syncthreads();
    norm_store<2>(accc, part0, mrow + 0 + 32 * w, fr);
    {
        f32x4 acc[8][3];
        wgemm<6, 3>(acc, CQ + fr * CQLD + 8 * fq, CQLD, (const bf16_t*)(ws + OFF_UQ + l * SZ_UQ) + (size_t)(48 * w + fr) * 192 + 8 * fq, 192);
        const int head = (3 * w) / 6, d0 = 16 * ((3 * w) % 6);
        u32x4 csn[16];
        if (w & 1) {
#pragma unroll
            for (int mt = 0; mt < 8; ++mt) { const float* rt = (const float*)(ws + OFF_ROPE) + (size_t)(c0 + 16 * mt + fr) * 32 + 4 * fq; csn[2 * mt] = *(const u32x4*)rt; csn[2 * mt + 1] = *(const u32x4*)(rt + 16); }
            pin(csn);
        }
#pragma unroll
        for (int mt = 0; mt < 8; ++mt) {
            const float rs = RSQ[16 * mt + fr];
            f32x4 a0 = acc[mt][0] * rs, a1 = acc[mt][1] * rs, a2 = acc[mt][2] * rs;
            if (w & 1) { const f32x4 cs = __builtin_bit_cast(f32x4, csn[2 * mt]), sn = __builtin_bit_cast(f32x4, csn[2 * mt + 1]); const f32x4 x1 = a1, x2 = a2; a1 = x1 * cs - x2 * sn; a2 = x2 * cs + x1 * sn; }
            bf16_t* qd = (bf16_t*)(ws + OFF_Q) + ((size_t)(bidx * 4 + head) * SEQ + s0 + 16 * mt + fr) * 96 + d0 + 4 * fq;
            u32x2 o; o.x = pk2(a0[0], a0[1]); o.y = pk2(a0[2], a0[3]); *(u32x2*)(qd) = o;
            o.x = pk2(a1[0], a1[1]); o.y = pk2(a1[2], a1[3]); *(u32x2*)(qd + 16) = o;
            o.x = pk2(a2[0], a2[1]); o.y = pk2(a2[2], a2[3]); *(u32x2*)(qd + 32) = o;
        }
    }
#pragma unroll 1
    for (int pz = 0; pz < 2; ++pz) {
        f32x4 acc[8][2];
        wgemm<4, 2>(acc, CK + fr * CKLD + 8 * fq, CKLD, (const bf16_t*)(ws + OFF_UKV + l * SZ_UKV) + (size_t)(64 * w + 32 * pz + fr) * 128 + 8 * fq, 128);
        const int head = w >> 1;
#pragma unroll
        for (int mt = 0; mt < 8; ++mt) {
            const float rs = RSK[16 * mt + fr]; const int spos = s0 + 16 * mt + fr;
#pragma unroll
            for (int n = 0; n < 2; ++n) {
                const f32x4 a = acc[mt][n] * rs; const unsigned p0 = pk2(a[0], a[1]), p1 = pk2(a[2], a[3]);
                if ((w & 1) == 0) { u32x2 o; o.x = p0; o.y = p1; *(u32x2*)((bf16_t*)(ws + OFF_K) + ((size_t)(bidx * 4 + head) * SEQ + spos) * 96 + 16 * (2 * pz + n) + 4 * fq) = o; }
                else { const int fp = ((fr & 4) << 1) | ((fr & 8) >> 1) | (fr & 3);
                    bf16_t* vv = (bf16_t*)(ws + OFF_VT) + ((size_t)(bidx * 4 + head) * 64 + 16 * (2 * pz + n) + 4 * fq) * SEQ + (spos - fr + fp);
                    vv[0] = (bf16_t)(p0 & 0xffff); vv[SEQ] = (bf16_t)(p0 >> 16); vv[2 * SEQ] = (bf16_t)(p1 & 0xffff); vv[3 * SEQ] = (bf16_t)(p1 >> 16); }
            }
        }
    }
    __syncthreads();
    {
        u32x4 zv[9];
#pragma unroll
        for (int i = 0; i < 9; ++i) { int q = tid + 512 * i; q = q < 143 * 32 ? q : 143 * 32 - 1; const int r = q >> 5, pc = q & 31; const int rr = (s0 - 15 + r >= 0) ? (c0 - 15 + r) : c0;
            zv[i] = *(const u32x4*)(zb + (size_t)rr * DIN_P + ZC_POOL + 8 * pc); }
        { u32x4 (&z8)[8] = *(u32x4 (*)[8])&zv[0]; pin(z8); }
#pragma unroll
        for (int i = 0; i < 9; ++i) { const int q = tid + 512 * i; if (q < 143 * 32) *(LAS u32x4*)(ZP + (q >> 5) * YLD + 8 * (q & 31)) = zv[i]; }
    }
    __syncthreads();
#pragma unroll
    for (int i = 0; i < 8; ++i) {
        const int g = i & 3, W = 2 << g, idx = tid + 512 * (i >> 2), r = idx >> 3, pc = 8 * g + (idx & 7);
        const int spos = s0 + r; const int cnt = (spos + 1) < W ? (spos + 1) : W; const float inv = 1.0f / (float)cnt;
        const LAS bf16_t* zp = ZP + (r + 15) * YLD + 8 * pc;
        float sum[8];
#pragma unroll
        for (int e = 0; e < 8; ++e) sum[e] = 0.f;
        const u32x4 self = *(const LAS u32x4*)zp;
#pragma unroll
        for (int j = 0; j < W; ++j) { const u32x4 v = *(const LAS u32x4*)(zp - j * YLD); const float m = j < cnt ? 1.f : 0.f;
#pragma unroll
            for (int e = 0; e < 4; ++e) { sum[2 * e] += m * bf_lo(v[e]); sum[2 * e + 1] += m * bf_hi(v[e]); } }
        u32x4 yv;
#pragma unroll
        for (int e = 0; e < 4; ++e) yv[e] = pk2(sum[2 * e] * inv - bf_lo(self[e]), sum[2 * e + 1] * inv - bf_hi(self[e]));
        *(LAS u32x4*)(YP + r * YLD + 8 * pc) = yv;
    }
    u32x4 vv[8];
    {
        const bf16_t* vr = zb + (size_t)(c0 + 16 * w + (lane >> 2)) * DIN_P + ZC_V + 64 * (lane & 3);
#pragma unroll
        for (int i = 0; i < 8; ++i) vv[i] = *(const u32x4*)(vr + 8 * i);
    }
    __syncthreads();
    f32x4 accp[8][2];
    {
        const int g = w >> 1, t0 = 2 * (w & 1);
        wgemm<2, 2>(accp, YP + fr * YLD + 64 * g + 8 * fq, YLD, (const bf16_t*)(ws + OFF_POOL + l * SZ_POOL) + (size_t)(64 * g + 16 * t0 + fr) * 64 + 8 * fq, 64);
        part_sumsq<2>(accp, part1, w, fr, fq);
    }
    {
        pin(vv);
        const int j = 16 * w + (lane >> 2), q4 = lane & 3; float ss = 0.f;
#pragma unroll
        for (int i = 0; i < 8; ++i) ss += sumsq8(vv[i]);
        ss += __shfl_xor(ss, 1); ss += __shfl_xor(ss, 2);
        const float rs = rsq(ss * (1.0f / 256.0f) + EPS);
        const float* gg = p->gmlp_norm_g + l * 256 + 64 * q4;
#pragma unroll
        for (int i = 0; i < 8; ++i) {
            const f32x4 g0 = *(const f32x4*)(gg + 8 * i), g1 = *(const f32x4*)(gg + 8 * i + 4);
#pragma unroll
            for (int e = 0; e < 4; ++e) { const int d = 8 * i + 2 * e; const float ga = e < 2 ? g0[2 * e] : g1[2 * e - 4], gb = e < 2 ? g0[2 * e + 1] : g1[2 * e - 3];
                const unsigned pk = pk2(bf_lo(vv[i][e]) * rs * ga, bf_hi(vv[i][e]) * rs * gb);
                VT[(64 * q4 + d) * VLD + j] = (bf16_t)(pk & 0xffff); VT[(64 * q4 + d + 1) * VLD + j] = (bf16_t)(pk >> 16); }
        }
    }
    __syncthreads();
    norm_store<2>(accp, part1, mrow + 512 + 64 * (w >> 1) + 32 * (w & 1), fr);
    {
        const int h = w >> 1, t0 = 2 * (w & 1);
        bf16x8 vf[2][4];
#pragma unroll
        for (int n = 0; n < 2; ++n)
#pragma unroll
            for (int ks = 0; ks < 4; ++ks) vf[n][ks] = *(const LAS bf16x8*)(VT + (64 * h + 16 * (t0 + n) + fr) * VLD + 32 * ks + 8 * fq);
        const bf16_t* gwp = (const bf16_t*)(ws + OFF_GWS + l * SZ_GWS) + (size_t)(h * 128 + fr) * 128 + 8 * fq;
        u32x2 uu[16]; float bias[8];
#pragma unroll
        for (int mt = 0; mt < 8; ++mt) {
            bias[mt] = p->gmlp_bs[(l * 4 + h) * 128 + 16 * mt + fr];
#pragma unroll
            for (int n = 0; n < 2; ++n) uu[2 * mt + n] = *(const u32x2*)(zb + (size_t)(c0 + 16 * mt + fr) * DIN_P + ZC_U + 64 * h + 16 * (t0 + n) + 4 * fq);
        }
        f32x4 acc[8][2];
#pragma unroll
        for (int mp = 0; mp < 4; ++mp) {
            u32x4 wf[8];
#pragma unroll
            for (int q = 0; q < 2; ++q)
#pragma unroll
                for (int ks = 0; ks < 4; ++ks) wf[4 * q + ks] = *(const u32x4*)(gwp + (size_t)(16 * (2 * mp + q)) * 128 + 32 * (ks <= mp ? ks : 0));
            pin(wf);
#pragma unroll
            for (int q = 0; q < 2; ++q)
#pragma unroll
                for (int n = 0; n < 2; ++n) { f32x4 a = (f32x4){0.f, 0.f, 0.f, 0.f};
#pragma unroll
                    for (int ks = 0; ks < 4; ++ks) if (ks <= mp) a = mfma16(vf[n][ks], as_bf16x8(wf[4 * q + ks]), a);
                    const int mt = 2 * mp + q; const u32x2 u2 = uu[2 * mt + n]; const float bs_ = bias[mt];
                    a[0] = bf_lo(u2.x) * (a[0] + bs_); a[1] = bf_hi(u2.x) * (a[1] + bs_); a[2] = bf_lo(u2.y) * (a[2] + bs_); a[3] = bf_hi(u2.y) * (a[3] + bs_);
                    acc[mt][n] = a; }
        }
        part_sumsq<2>(acc, part0, w, fr, fq);
        __syncthreads();
        norm_store<2>(acc, part0, mrow + 768 + 64 * h + 16 * t0, fr);
    }
    __syncthreads();
}

constexpr int KLD = 104, VSLD = 136, KS_BYTES = 128 * KLD * 2, VS_BYTES = 64 * VSLD * 2, KV_BUF = KS_BYTES + VS_BYTES;

__device__ __forceinline__ void attn_block(KP p, LAS unsigned char* lds, int bh, int q0) {
    int tid = threadIdx.x; asm volatile("" : "+v"(tid));
    const int lane = tid & 63, w = __builtin_amdgcn_readfirstlane(tid >> 6), lr = lane & 31, lh = lane >> 5;
    unsigned char* ws = p->ws;
    const bf16_t* Qg = (const bf16_t*)(ws + OFF_Q) + (size_t)bh * SEQ * 96;
    const bf16_t* Kg = (const bf16_t*)(ws + OFF_K) + (size_t)bh * SEQ * 96;
    const bf16_t* Vg = (const bf16_t*)(ws + OFF_VT) + (size_t)bh * 64 * SEQ;
    const int qrow = q0 + 32 * w + lr, wave_q0 = q0 + 32 * w;
    bf16x8 qf[6];
#pragma unroll
    for (int ks = 0; ks < 6; ++ks) qf[ks] = *(const bf16x8*)(Qg + (size_t)qrow * 96 + 16 * ks + 8 * lh);
    f32x16 o0, o1;
#pragma unroll
    for (int i = 0; i < 16; ++i) { o0[i] = 0.f; o1[i] = 0.f; }
    float mrun = -1e30f, lrun = 0.f;
    const int nst = (q0 + 256) / 128;
    u32x4 rk[3], rv[2];
#pragma unroll
    for (int i = 0; i < 3; ++i) { const int q = tid + 512 * i; rk[i] = *(const u32x4*)(Kg + (size_t)(q / 12) * 96 + 8 * (q % 12)); }
#pragma unroll
    for (int i = 0; i < 2; ++i) { const int q = tid + 512 * i; rv[i] = *(const u32x4*)(Vg + (size_t)(q >> 4) * SEQ + 8 * (q & 15)); }
    for (int st = 0; st < nst; ++st) {
        LAS bf16_t* ksm0 = (LAS bf16_t*)(lds + (st & 1) * KV_BUF); LAS bf16_t* vsm0 = (LAS bf16_t*)(lds + (st & 1) * KV_BUF + KS_BYTES);
#pragma unroll
        for (int i = 0; i < 3; ++i) { const int q = tid + 512 * i; *(LAS u32x4*)(ksm0 + (q / 12) * KLD + 8 * (q % 12)) = rk[i]; }
#pragma unroll
        for (int i = 0; i < 2; ++i) { const int q = tid + 512 * i; *(LAS u32x4*)(vsm0 + (q >> 4) * VSLD + 8 * (q & 15)) = rv[i]; }
        if (st + 1 < nst) {
            const int k1 = 128 * (st + 1);
#pragma unroll
            for (int i = 0; i < 3; ++i) { const int q = tid + 512 * i; rk[i] = *(const u32x4*)(Kg + (size_t)(k1 + q / 12) * 96 + 8 * (q % 12)); }
#pragma unroll
            for (int i = 0; i < 2; ++i) { const int q = tid + 512 * i; rv[i] = *(const u32x4*)(Vg + (size_t)(q >> 4) * SEQ + k1 + 8 * (q & 15)); }
        }
        __syncthreads();
#pragma unroll
        for (int sub = 0; sub < 2; ++sub) {
        const int kt = 2 * st + sub;
        const LAS bf16_t* ksm = ksm0 + 64 * sub * KLD; const LAS bf16_t* vsm = vsm0 + 64 * sub;
        if (64 * kt <= wave_q0 + 31) {
            f32x16 s0, s1;
#pragma unroll
            for (int i = 0; i < 16; ++i) { s0[i] = 0.f; s1[i] = 0.f; }
            u32x4 ka[6], kb[6];
#pragma unroll
            for (int ks = 0; ks < 6; ++ks) { ka[ks] = *(const LAS u32x4*)(ksm + lr * KLD + 16 * ks + 8 * lh); kb[ks] = *(const LAS u32x4*)(ksm + (32 + lr) * KLD + 16 * ks + 8 * lh); }
            pin(ka); pin(kb);
#pragma unroll
            for (int ks = 0; ks < 6; ++ks) { s0 = mfma32(as_bf16x8(ka[ks]), qf[ks], s0); s1 = mfma32(as_bf16x8(kb[ks]), qf[ks], s1); }
            u32x4 va[4], vb[4];
#pragma unroll
            for (int q = 0; q < 4; ++q) { const LAS bf16_t* vp = vsm + lr * VSLD + 16 * q + 8 * lh; va[q] = *(const LAS u32x4*)vp; vb[q] = *(const LAS u32x4*)(vp + 32 * VSLD); }
            if (64 * kt + 63 > wave_q0) {
#pragma unroll
                for (int i = 0; i < 16; ++i) { const int key = 64 * kt + (i & 3) + 8 * (i >> 2) + 4 * lh;
                    if (key > qrow) s0[i] = -1e30f; if (key + 32 > qrow) s1[i] = -1e30f; }
            }
            float mx = s0[0];
#pragma unroll
            for (int i = 1; i < 16; ++i) mx = fmaxf(mx, s0[i]);
#pragma unroll
            for (int i = 0; i < 16; ++i) mx = fmaxf(mx, s1[i]);
            mx = fmaxf(mx, __shfl_xor(mx, 32));
            if (__builtin_amdgcn_ballot_w64(mx > mrun) != 0ull) {
                const float mnew = fmaxf(mrun, mx), alpha = fast_exp2(mrun - mnew);
                lrun *= alpha; mrun = mnew; o0 = o0 * alpha; o1 = o1 * alpha;
            }
            float rsum = 0.f;
#pragma unroll
            for (int i = 0; i < 16; ++i) { s0[i] = fast_exp2(s0[i] - mrun); s1[i] = fast_exp2(s1[i] - mrun); rsum += s0[i] + s1[i]; }
            lrun += rsum;
            pin(va); pin(vb);
#pragma unroll
            for (int q = 0; q < 4; ++q) {
                u32x4 pw;
#pragma unroll
                for (int e = 0; e < 4; ++e) pw[e] = (q >> 1) == 0 ? pk2(s0[8 * (q & 1) + 2 * e], s0[8 * (q & 1) + 2 * e + 1]) : pk2(s1[8 * (q & 1) + 2 * e], s1[8 * (q & 1) + 2 * e + 1]);
                const bf16x8 pf = as_bf16x8(pw);
                o0 = mfma32(as_bf16x8(va[q]), pf, o0); o1 = mfma32(as_bf16x8(vb[q]), pf, o1);
            }
        }
        }
    }
    const float ltot = lrun + __shfl_xor(lrun, 32), inv = fast_rcp(ltot);
    o0 = o0 * inv; o1 = o1 * inv;
    float ss = 0.f;
#pragma unroll
    for (int i = 0; i < 16; ++i) ss += o0[i] * o0[i] + o1[i] * o1[i];
    ss += __shfl_xor(ss, 32);
    const int b = bh >> 2, hd = bh & 3; const size_t grow = (size_t)b * SEQ + qrow;
    if (lh == 0) ((float*)(ws + OFF_SSQM))[grow * 4 + hd] = ss;
    bf16_t* od = (bf16_t*)(ws + OFF_MIX) + grow * DM + 256 + 64 * hd + 4 * lh;
#pragma unroll
    for (int g = 0; g < 4; ++g) {
        u32x2 a, c; a.x = pk2(o0[4 * g], o0[4 * g + 1]); a.y = pk2(o0[4 * g + 2], o0[4 * g + 3]); c.x = pk2(o1[4 * g], o1[4 * g + 1]); c.y = pk2(o1[4 * g + 2], o1[4 * g + 3]);
        *(u32x2*)(od + 8 * g) = a; *(u32x2*)(od + 32 + 8 * g) = c;
    }
    __syncthreads();
}


#define XB_TMO      128
#define XB_XCNT(j)  (256  + 64 * (j))
#define XB_XSUB(j)  (1280 + 64 * (j))
#define XB_XGEN(j)  (2304 + 64 * (j))
#define XB_TOP      3328
#define XB_TOPGEN   3392
#define XB_SPIN_CAP (1u << 20)
__device__ __forceinline__ unsigned xb_ld(unsigned* p)              { return __hip_atomic_load(p, __ATOMIC_RELAXED, __HIP_MEMORY_SCOPE_AGENT); }
__device__ __forceinline__ unsigned xb_add(unsigned* p, unsigned v) { return __hip_atomic_fetch_add(p, v, __ATOMIC_RELAXED, __HIP_MEMORY_SCOPE_AGENT); }
__device__ __forceinline__ unsigned xb_xcc_id() { return (unsigned)__builtin_amdgcn_s_getreg((3 << 11) | 20) & 0xFu; }
#define XB_SPIN(cond, bar) do { unsigned _sp = 0; while (cond) { __builtin_amdgcn_s_sleep(1); \
    if ((++_sp & 255u) == 0u) { if (xb_ld(&(bar)[XB_TMO])) break; if (_sp > XB_SPIN_CAP) { atomicAdd(&(bar)[XB_TMO], 1u); break; } } } } while (0)
__device__ __forceinline__ void xb_complete(unsigned* bar, unsigned x, unsigned& nloc, unsigned& nx) {
    const unsigned G = gridDim.x;
    unsigned sum, cnt, mine, sp = 0u;
    for (;;) {
        sum = 0u; cnt = 0u; mine = 0u;
#pragma unroll
        for (unsigned j = 0; j < 16; ++j) { const unsigned c = xb_ld(&bar[XB_XCNT(j)]); sum += c; cnt += (c > 0u) ? 1u : 0u; mine = (j == x) ? c : mine; }
        if (sum == G) break;
        __builtin_amdgcn_s_sleep(1);
        if ((++sp & 255u) == 0u) { if (xb_ld(&bar[XB_TMO])) break; if (sp > XB_SPIN_CAP) { atomicAdd(&bar[XB_TMO], 1u); break; } }
    }
    nloc = mine > 0u ? mine : 1u; nx = cnt > 0u ? cnt : 1u;
}
__device__ __forceinline__ void grid_barrier(unsigned* bar, const unsigned x, unsigned& nloc, unsigned& nx) {
    asm volatile("s_waitcnt vmcnt(0) lgkmcnt(0)" ::: "memory");
    __syncthreads();
    if (threadIdx.x == 0) {
        __builtin_amdgcn_s_waitcnt(0);
        if (nloc == 0u) xb_complete(bar, x, nloc, nx);
        const unsigned old = xb_add(&bar[XB_XSUB(x)], 1u);
        const unsigned gen = old / nloc;
        if (old + 1u == (gen + 1u) * nloc) {
            __builtin_amdgcn_fence(__ATOMIC_RELEASE, "agent");
            asm volatile("s_waitcnt vmcnt(0)" ::: "memory");
            const unsigned og = xb_add(&bar[XB_TOP], 1u);
            const unsigned tg = og / nx;
            if (og + 1u == (tg + 1u) * nx) xb_add(&bar[XB_TOPGEN], 1u);
            else XB_SPIN(xb_ld(&bar[XB_TOPGEN]) == tg, bar);
            __builtin_amdgcn_fence(__ATOMIC_ACQUIRE, "agent");
            xb_add(&bar[XB_XGEN(x)], 1u);
            asm volatile("s_waitcnt vmcnt(0)" ::: "memory");
        } else {
            XB_SPIN(xb_ld(&bar[XB_XGEN(x)]) == gen, bar);
            __builtin_amdgcn_fence(__ATOMIC_ACQUIRE, "agent");
            asm volatile("s_waitcnt vmcnt(0)" ::: "memory");
        }
    }
    __syncthreads();
    nloc = __builtin_amdgcn_readfirstlane(nloc); nx = __builtin_amdgcn_readfirstlane(nx);
}

__global__ void __launch_bounds__(512) fwd_kernel(Params p_arg) {
    extern __shared__ __attribute__((aligned(16))) unsigned char smem[];
    LAS unsigned char* lds = (LAS unsigned char*)smem;
    cg::grid_group grid = cg::this_grid();
    const int ph_lo = p_arg.ph_lo, ph_hi = p_arg.ph_hi;
    unsigned nbar = 0;
    unsigned* const xbar = (unsigned*)(p_arg.ws + OFF_BAR); const unsigned xcc = xb_xcc_id(); unsigned xb_nloc = 0u, xb_nx = 0u;
    if (threadIdx.x == 0) (void)xb_add(&xbar[XB_XCNT(xcc)], 1u);
    if (ph_lo < 0) grid.sync();
    for (int ph = ph_lo; ph < ph_hi; ++ph)
    for (int rep = 0; rep < 1 + ((DUP_MASK >> (ph == 0 ? 0 : (ph == 1 + 7 * DEPTH ? 31 : 1 + (ph - 1) % 7))) & 1); ++rep) {
        if (ph > ph_lo || rep > 0) {
            ++nbar;
            grid_barrier(xbar, xcc, xb_nloc, xb_nx);
        }
        KP p = (KP)__builtin_amdgcn_kernarg_segment_ptr();
        asm volatile("" : "+s"(p));
        unsigned char* ws = p->ws;
        int tid = threadIdx.x; asm volatile("" : "+v"(tid));
        const int lane = tid & 63, wave = tid >> 6;
        const int gw = blockIdx.x * 8 + wave, NGW = gridDim.x * 8;
        if (ph == 0) {
#if PH_MASK & 1
 phase_prologue(p, lds);
#endif
 continue; }
        if (ph == 1 + 7 * DEPTH) {
            const float* ssq = (const float*)(ws + OFF_SSQA);
            for (int r4 = gw; r4 < M_TOK / 4; r4 += NGW) {
                u32x4 xv[8];
#pragma unroll
                for (int q = 0; q < 4; ++q)
#pragma unroll
                    for (int j = 0; j < 2; ++j) xv[2 * q + j] = *((const u32x4*)((const bf16_t*)(ws + OFF_HB) + (size_t)(4 * r4 + q) * DM) + lane + 64 * j);
                float sp = ssq[(size_t)(4 * r4) * 16 + lane];
                pin(xv);
                sp += __shfl_xor(sp, 1); sp += __shfl_xor(sp, 2); sp += __shfl_xor(sp, 4); sp += __shfl_xor(sp, 8);
                const float rsl = rsq(sp * (1.0f / DM) + EPS);
#pragma unroll
                for (int q = 0; q < 4; ++q) {
                    const float rs = __shfl(rsl, 16 * q);
#pragma unroll
                    for (int j = 0; j < 2; ++j) {
                        const f32x4* gg = (const f32x4*)(p->final_norm_g + 512 * j + 8 * lane); const f32x4 g0 = gg[0], g1 = gg[1]; const u32x4 v = xv[2 * q + j];
                        f32x4* orow = (f32x4*)(p->out + (size_t)(4 * r4 + q) * DM + 512 * j + 8 * lane);
                        orow[0] = (f32x4){bf_lo(v.x) * rs * g0[0], bf_hi(v.x) * rs * g0[1], bf_lo(v.y) * rs * g0[2], bf_hi(v.y) * rs * g0[3]};
                        orow[1] = (f32x4){bf_lo(v.z) * rs * g1[0], bf_hi(v.z) * rs * g1[1], bf_lo(v.w) * rs * g1[2], bf_hi(v.w) * rs * g1[3]};
                    }
                }
            }
            continue;
        }
        const int l = (ph - 1) / 7, sub = (ph - 1) % 7;
        pg8::StaticOrder S;
#if PH_MASK & 2
        if (sub == 0) {
            pg8::Gemm g{(const bf16_t*)(ws + OFF_HB), (const bf16_t*)(ws + OFF_WIN + l * SZ_WIN), M_TOK, DIN_P, DM};
            S.init(M_TOK, DIN_P, gridDim.x, blockIdx.x);
            LAS float* rstab = (LAS float*)(lds + pg8::STAGE_BYTES);
            pg8::build_rs_table(rstab, S, (const float*)(ws + OFF_SSQA));
            pg8::EpiScaleBf16<0> E{(bf16_t*)(ws + OFF_ZB), DIN_P, rstab};
            pg8::gemm_phase(lds, g, S, E);
        } else
#endif
#if PH_MASK & 4
        if (sub == 1) {
            for (int ch = blockIdx.x; ch < M_TOK / 128; ch += gridDim.x) mixer_chunk(p, lds, l, ch);
        } else
#endif
#if PH_MASK & 8
        if (sub == 2) {
            for (int it0 = blockIdx.x; it0 < 256; it0 += gridDim.x) { const int it = (it0 & 7) * 32 + (it0 >> 3);
                const int bh = it >> 3, pr = it & 7; attn_block(p, lds, bh, 256 * pr); attn_block(p, lds, bh, 256 * (15 - pr)); }
        } else
#endif
        if (sub == 3) {
            const float* sm = (const float*)(ws + OFF_SSQM); bf16_t* mixed = (bf16_t*)(ws + OFF_MIX);
            for (int r8 = gw; r8 < M_TOK / 8; r8 += NGW) {
                u32x4 mv[4]; f32x4 s4[4];
#pragma unroll
                for (int q = 0; q < 4; ++q) { const int row = 8 * r8 + 2 * q + (lane >> 5); s4[q] = *(const f32x4*)(sm + (size_t)row * 4); mv[q] = *(const u32x4*)(mixed + (size_t)row * DM + 256 + 8 * (lane & 31)); }
                pin(mv);
#pragma unroll
                for (int q = 0; q < 4; ++q) { const int row = 8 * r8 + 2 * q + (lane >> 5);
                    const float rs = rsq(((s4[q][0] + s4[q][1]) + (s4[q][2] + s4[q][3])) * (1.0f / 256.0f) + EPS); u32x4 v = mv[q];
#pragma unroll
                    for (int e = 0; e < 4; ++e) v[e] = pk2(bf_lo(v[e]) * rs, bf_hi(v[e]) * rs);
                    *(u32x4*)(mixed + (size_t)row * DM + 256 + 8 * (lane & 31)) = v; }
            }
        } else
#if PH_MASK & 16
        if (sub == 4) {
            pg8::Gemm g{(const bf16_t*)(ws + OFF_MIX), (const bf16_t*)(ws + OFF_WOUT + l * SZ_WOUT), M_TOK, DM, DM};
            S.init(M_TOK, DM, gridDim.x, blockIdx.x);
            pg8::EpiResidual E{(bf16_t*)(ws + OFF_HB), (float*)(ws + OFF_SSQF)};
            pg8::gemm_phase(lds, g, S, E);
        } else
#endif
#if PH_MASK & 32
        if (sub == 5) {
            pg8::Gemm g{(const bf16_t*)(ws + OFF_HB), (const bf16_t*)(ws + OFF_W1 + l * SZ_W1), M_TOK, DFF, DM};
            S.init(M_TOK, DFF, gridDim.x, blockIdx.x);
            LAS float* rstab = (LAS float*)(lds + pg8::STAGE_BYTES);
            pg8::build_rs_table(rstab, S, (const float*)(ws + OFF_SSQF));
            pg8::EpiScaleBf16<1> E{(bf16_t*)(ws + OFF_FB), DFF, rstab};
            pg8::gemm_phase(lds, g, S, E);
        } else
#endif
#if PH_MASK & 64
        if (sub == 6) {
            pg8::Gemm g{(const bf16_t*)(ws + OFF_FB), (const bf16_t*)(ws + OFF_W2 + l * SZ_W2), M_TOK, DM, DFF};
            S.init(M_TOK, DM, gridDim.x, blockIdx.x);
            pg8::EpiResidual E{(bf16_t*)(ws + OFF_HB), (float*)(ws + OFF_SSQA)};
            pg8::gemm_phase(lds, g, S, E);
        }
#endif
        {}
    }
}

#ifndef N_LAUNCH_MODE
#define N_LAUNCH_MODE 0
#endif

extern "C" void kernel_launch(void* const* d_in, const int* in_sizes, int n_in, void* d_out, int out_size, void* d_ws, size_t ws_size, hipStream_t stream) {
    static int grid = 0;
    if (grid == 0) {
        if (n_in != 24 || ws_size < WS_TOTAL) { fprintf(stderr, "kernel_launch: unexpected n_in %d / ws_size %zu (need %zu)\n", n_in, ws_size, (size_t)WS_TOTAL); grid = -1; return; }
        int dev = 0, cus = 0, per_cu = 0;
        hipGetDevice(&dev); hipDeviceGetAttribute(&cus, hipDeviceAttributeMultiprocessorCount, dev);
        if (hipFuncSetAttribute((const void*)fwd_kernel, hipFuncAttributeMaxDynamicSharedMemorySize, LDS_BYTES) != hipSuccess) { fprintf(stderr, "kernel_launch: hipFuncSetAttribute failed\n"); grid = -1; return; }
        if (hipOccupancyMaxActiveBlocksPerMultiprocessor(&per_cu, (const void*)fwd_kernel, 512, LDS_BYTES) != hipSuccess || per_cu < 1) { fprintf(stderr, "kernel_launch: occupancy query says %d\n", per_cu); per_cu = 1; }
        (void)hipGetLastError();
        grid = cus * 1;
    }
    if (grid < 0) return;
    Params p{};
    p.x = (const float*)d_in[0]; p.positions = (const int*)d_in[1]; p.mix_norm_g = (const float*)d_in[2]; p.w_in = (const float*)d_in[3]; p.conv_dw_w = (const float*)d_in[4];
    p.conv_dw_b = (const float*)d_in[5]; p.conv_ln_g = (const float*)d_in[6]; p.conv_ln_b = (const float*)d_in[7]; p.conv_pw_w = (const float*)d_in[8]; p.mla_q_norm_g = (const float*)d_in[9];
    p.mla_w_uq = (const float*)d_in[10]; p.mla_kv_norm_g = (const float*)d_in[11]; p.mla_w_ukv = (const float*)d_in[12]; p.pool_w = (const float*)d_in[13]; p.pool_scale = (const float*)d_in[14];
    p.gmlp_norm_g = (const float*)d_in[15]; p.gmlp_ws = (const float*)d_in[16]; p.gmlp_bs = (const float*)d_in[17]; p.group_norm_g = (const float*)d_in[18]; p.w_out = (const float*)d_in[19];
    p.ffn_norm_g = (const float*)d_in[20]; p.w_ff1 = (const float*)d_in[21]; p.w_ff2 = (const float*)d_in[22]; p.final_norm_g = (const float*)d_in[23];
    p.out = (float*)d_out; p.ws = (unsigned char*)d_ws;
    constexpr int NPH = 2 + 7 * DEPTH;
#if N_LAUNCH_MODE == 0
    p.ph_lo = 0; p.ph_hi = NPH;
    (void)hipMemsetAsync((unsigned char*)d_ws + OFF_BAR, 0, 16384, stream);
    void* args[] = {&p};
    hipError_t e = hipLaunchCooperativeKernel((const void*)fwd_kernel, dim3(grid), dim3(512), args, LDS_BYTES, stream);
    if (e != hipSuccess) fprintf(stderr, "cooperative launch failed: %s (grid %d)\n", hipGetErrorString(e), grid);
#else
    for (int ph = 0; ph < NPH; ++ph) { p.ph_lo = ph; p.ph_hi = ph + 1; hipLaunchKernelGGL(fwd_kernel, dim3(grid), dim3(512), LDS_BYTES, stream, p); }
#endif
}
```

```cpp
#include <hip/hip_runtime.h>
#include <hip/hip_cooperative_groups.h>
#include <cstdio>
namespace cg = cooperative_groups;
#ifndef DUP_MASK
#define DUP_MASK 0
#endif
#ifndef MIX_MASK
#define MIX_MASK 15
#endif
#ifndef PH_MASK
#define PH_MASK 127
#endif

#define LAS __attribute__((address_space(3)))
typedef unsigned short bf16_t;
typedef short bf16x8 __attribute__((ext_vector_type(8)));
typedef short bf16x4 __attribute__((ext_vector_type(4)));
typedef float f32x4 __attribute__((ext_vector_type(4)));
typedef float f32x2 __attribute__((ext_vector_type(2)));
typedef float f32x16 __attribute__((ext_vector_type(16)));
typedef unsigned u32x4 __attribute__((ext_vector_type(4)));
typedef unsigned u32x2 __attribute__((ext_vector_type(2)));

constexpr int M_TOK = 32768, DM = 1024, SEQ = 4096, DEPTH = 4;
constexpr int DIN = 1632, DIN_P = 1792, DFF = 4096;
constexpr int ZC_G = 256, ZC_CQ = 512, ZC_CKV = 704, ZC_KR = 832, ZC_POOL = 864, ZC_U = 1120, ZC_V = 1376;
constexpr float EPS = 1e-6f;
constexpr float QSCALE = 0.14724444602590306f;

__constant__ float INV_FREQ[16] = {1.000000000e+00f, 5.623413324e-01f, 3.162277639e-01f, 1.778279394e-01f, 1.000000015e-01f, 5.623413250e-02f, 3.162277490e-02f, 1.778279431e-02f,
                                   9.999999776e-03f, 5.623413250e-03f, 3.162277630e-03f, 1.778279431e-03f, 1.000000047e-03f, 5.623413017e-04f, 3.162277571e-04f, 1.778279402e-04f};

constexpr size_t SZ_WIN = (size_t)DIN_P * DM * 2, SZ_WOUT = (size_t)DM * DM * 2, SZ_W1 = (size_t)DFF * DM * 2, SZ_W2 = SZ_W1;
constexpr size_t SZ_PW = 256 * 256 * 2, SZ_UQ = 384 * 192 * 2, SZ_UKV = 512 * 128 * 2, SZ_POOL = 4 * 64 * 64 * 2, SZ_GWS = 4 * 128 * 128 * 2;
constexpr size_t OFF_WIN = 0;
constexpr size_t OFF_WOUT = OFF_WIN + DEPTH * SZ_WIN;
constexpr size_t OFF_W1 = OFF_WOUT + DEPTH * SZ_WOUT;
constexpr size_t OFF_W2 = OFF_W1 + DEPTH * SZ_W1;
constexpr size_t OFF_PW = OFF_W2 + DEPTH * SZ_W2;
constexpr size_t OFF_UQ = OFF_PW + DEPTH * SZ_PW;
constexpr size_t OFF_UKV = OFF_UQ + DEPTH * SZ_UQ;
constexpr size_t OFF_POOL = OFF_UKV + DEPTH * SZ_UKV;
constexpr size_t OFF_GWS = OFF_POOL + DEPTH * SZ_POOL;
constexpr size_t OFF_HB = OFF_GWS + DEPTH * SZ_GWS;
constexpr size_t OFF_SSQA = OFF_HB + (size_t)M_TOK * DM * 2;
constexpr size_t OFF_SSQF = OFF_SSQA + (size_t)M_TOK * 16 * 4;
constexpr size_t OFF_SSQM = OFF_SSQF + (size_t)M_TOK * 16 * 4;
constexpr size_t OFF_ROPE = OFF_SSQM + (size_t)M_TOK * 4 * 4;
constexpr size_t OFF_UNION = OFF_ROPE + (size_t)M_TOK * 32 * 4;
constexpr size_t OFF_ZB = OFF_UNION;
constexpr size_t OFF_MIX = OFF_ZB + (size_t)M_TOK * DIN_P * 2;
constexpr size_t OFF_Q = OFF_MIX + (size_t)M_TOK * DM * 2;
constexpr size_t OFF_K = OFF_Q + (size_t)M_TOK * 384 * 2;
constexpr size_t OFF_VT = OFF_K + (size_t)M_TOK * 384 * 2;
constexpr size_t OFF_FB = OFF_UNION;
constexpr size_t WS_END = OFF_UNION + (size_t)M_TOK * DFF * 2;
constexpr size_t OFF_BAR = WS_END;
constexpr size_t WS_TOTAL = WS_END + 16384;
static_assert(OFF_VT + (size_t)M_TOK * 256 * 2 <= WS_END, "union overflow");
static_assert(OFF_HB % 256 == 0 && OFF_UNION % 256 == 0, "align");

constexpr int LDS_BYTES = 163840;

struct Params;
typedef const __attribute__((address_space(4))) Params* KP;
struct Params {
    const float* x; const int* positions; const float* mix_norm_g; const float* w_in; const float* conv_dw_w; const float* conv_dw_b; const float* conv_ln_g; const float* conv_ln_b;
    const float* conv_pw_w; const float* mla_q_norm_g; const float* mla_w_uq; const float* mla_kv_norm_g; const float* mla_w_ukv; const float* pool_w; const float* pool_scale;
    const float* gmlp_norm_g; const float* gmlp_ws; const float* gmlp_bs; const float* group_norm_g; const float* w_out; const float* ffn_norm_g; const float* w_ff1; const float* w_ff2;
    const float* final_norm_g;
    float* out; unsigned char* ws;
    int ph_lo, ph_hi;
};

__device__ __forceinline__ unsigned pk2(float lo, float hi) { unsigned r; asm("v_cvt_pk_bf16_f32 %0, %1, %2" : "=v"(r) : "v"(lo), "v"(hi)); return r; }
__device__ __forceinline__ float bf_lo(unsigned w) { return __uint_as_float(w << 16); }
__device__ __forceinline__ float bf_hi(unsigned w) { return __uint_as_float(w & 0xffff0000u); }
__device__ __forceinline__ float wave_sum(float v) {
#pragma unroll
    for (int o = 1; o < 64; o <<= 1) v += __shfl_xor(v, o);
    return v;
}
__device__ __forceinline__ f32x4 mfma16(bf16x8 a, bf16x8 b, f32x4 c) { return __builtin_amdgcn_mfma_f32_16x16x32_bf16(a, b, c, 0, 0, 0); }
__device__ __forceinline__ f32x16 mfma32(bf16x8 a, bf16x8 b, f32x16 c) { return __builtin_amdgcn_mfma_f32_32x32x16_bf16(a, b, c, 0, 0, 0); }
__device__ __forceinline__ float fast_rcp(float x) { return __builtin_amdgcn_rcpf(x); }
__device__ __forceinline__ float fast_exp2(float x) { return __builtin_amdgcn_exp2f(x); }
__device__ __forceinline__ float sigmoidf_(float x) { return fast_rcp(1.0f + fast_exp2(-1.4426950408889634f * x)); }
__device__ __forceinline__ float sumsq8(u32x4 v) {
    float s = 0.f;
#pragma unroll
    for (int i = 0; i < 4; ++i) { const float a = bf_lo(v[i]), b = bf_hi(v[i]); s += a * a + b * b; }
    return s;
}
__device__ __forceinline__ bf16x8 as_bf16x8(u32x4 v) { return __builtin_bit_cast(bf16x8, v); }

template <int N> __device__ __forceinline__ void pin(u32x4 (&b)[N]) {
    static_assert(N == 2 || N == 4 || N == 5 || N == 6 || N == 8 || N == 16, "pin size");
    if constexpr (N == 2) asm volatile("" : "+v"(b[0]), "+v"(b[1]));
    else if constexpr (N == 4) asm volatile("" : "+v"(b[0]), "+v"(b[1]), "+v"(b[2]), "+v"(b[3]));
    else if constexpr (N == 5) asm volatile("" : "+v"(b[0]), "+v"(b[1]), "+v"(b[2]), "+v"(b[3]), "+v"(b[4]));
    else if constexpr (N == 6) asm volatile("" : "+v"(b[0]), "+v"(b[1]), "+v"(b[2]), "+v"(b[3]), "+v"(b[4]), "+v"(b[5]));
    else if constexpr (N == 8) asm volatile("" : "+v"(b[0]), "+v"(b[1]), "+v"(b[2]), "+v"(b[3]), "+v"(b[4]), "+v"(b[5]), "+v"(b[6]), "+v"(b[7]));
    else asm volatile("" : "+v"(b[0]), "+v"(b[1]), "+v"(b[2]), "+v"(b[3]), "+v"(b[4]), "+v"(b[5]), "+v"(b[6]), "+v"(b[7]), "+v"(b[8]), "+v"(b[9]), "+v"(b[10]), "+v"(b[11]), "+v"(b[12]), "+v"(b[13]), "+v"(b[14]), "+v"(b[15]));
}
template <int N> __device__ __forceinline__ void ldfr(u32x4 (&b)[N], const bf16_t* ptr) {
#pragma unroll
    for (int ks = 0; ks < N; ++ks) b[ks] = *(const u32x4*)(ptr + 32 * ks);
}
__device__ __forceinline__ float rsq(float x) { return __builtin_amdgcn_rsqf(x); }


namespace pg8 {
constexpr int BM = 256, BK = 64, HALF = 128, HTB = HALF * BK * 2, STAGE_BYTES = 8 * HTB, NXCD = 8, WGM = 8;
__host__ __device__ __forceinline__ int lds_byte(int r, int c) { const int st = (r >> 4) * 2 + (c >> 5), rr = r & 15, cc = c & 31, ob = rr * 64 + cc * 2; return st * 1024 + (ob ^ (((ob >> 9) & 1) << 5)); }
__host__ __device__ __forceinline__ void stage_rc(int b, int& R, int& C) { const int st = b / 1024, sb = b % 1024, swz = sb ^ (((sb >> 9) & 1) << 5); R = (st >> 1) * 16 + swz / 64; C = (st & 1) * 32 + (swz % 64) / 2; }
__host__ __device__ __forceinline__ int perm32(int rho) { const int n = rho >> 4, i = rho & 15; return 8 * (i >> 2) + 4 * n + (i & 3); }
struct Unit { int pm, pn; };
struct Gemm { const bf16_t* A; const bf16_t* Bt; int M, N, K; };
struct StaticOrder {
    int nM, nN, nwg, G, c;
    __host__ __device__ void init(int M, int N, int G_, int c_) { nM = M / BM; nN = N / BM; nwg = nM * nN; G = G_; c = c_; }
    __host__ __device__ bool next(int i, Unit& u) const {
        const long L = (long)i * G + c; if (L >= nwg) return false;
        int wgid = (int)L; { const int q = nwg / NXCD, r = nwg % NXCD, xcd = wgid % NXCD, off = wgid / NXCD; wgid = (xcd < r ? xcd * (q + 1) : r * (q + 1) + (xcd - r) * q) + off; }
        const int nig = WGM * nN, gid = wgid / nig, fm = gid * WGM, gsz = (nM - fm) < WGM ? (nM - fm) : WGM;
        u.pm = fm + ((wgid % nig) % gsz); u.pn = (wgid % nig) / gsz; return true;
    }
};

__device__ __forceinline__ float row_rs(const float* ssq, int row) {
    const f32x4* p = (const f32x4*)(ssq + (size_t)row * 16);
    const f32x4 a = p[0], b = p[1], c = p[2], d = p[3];
    const float s = ((a[0] + a[1]) + (a[2] + a[3])) + ((b[0] + b[1]) + (b[2] + b[3])) + ((c[0] + c[1]) + (c[2] + c[3])) + ((d[0] + d[1]) + (d[2] + d[3]));
    return 1.0f / sqrtf(s * (1.0f / DM) + EPS);
}
template <int ACT  > struct EpiScaleBf16 {
    static constexpr bool PERM = true, MIDSCALE = false;
    bf16_t* O; int ldc; const LAS float* rstab;
    __device__ __forceinline__ void operator()(const f32x4 (&acc)[2][2][4][2], const Unit& u, int ui, int wr, int wc, int fr, int fq) const {
        const int lrow0 = wr * 64 + fr, row0 = u.pm * BM + lrow0, col0 = u.pn * BM + wc * 32 + 8 * fq;
        float rsv[2][4];
#pragma unroll
        for (int ai = 0; ai < 2; ++ai)
#pragma unroll
            for (int m = 0; m < 4; ++m) rsv[ai][m] = rstab[ui * 256 + lrow0 + ai * HALF + m * 16];
#pragma unroll
        for (int ai = 0; ai < 2; ++ai)
#pragma unroll
            for (int m = 0; m < 4; ++m) {
                const int row = row0 + ai * HALF + m * 16; const float rs = rsv[ai][m];
                bf16_t* rowp = O + (size_t)row * ldc + col0;
#pragma unroll
                for (int bj = 0; bj < 2; ++bj) {
                    f32x4 v0 = acc[ai][bj][m][0] * rs, v1 = acc[ai][bj][m][1] * rs;
                    if (ACT == 1) {
#pragma unroll
                        for (int j = 0; j < 4; ++j) { const float a = fmaxf(v0[j], 0.f), b = fmaxf(v1[j], 0.f); v0[j] = a * a; v1[j] = b * b; }
                    }
                    u32x4 w; w.x = pk2(v0[0], v0[1]); w.y = pk2(v0[2], v0[3]); w.z = pk2(v1[0], v1[1]); w.w = pk2(v1[2], v1[3]);
                    *(u32x4*)(rowp + bj * HALF) = w;
                }
            }
    }
};
__device__ __forceinline__ void build_rs_table(LAS float* rstab, const StaticOrder& S, const float* ssq) {
    int tid = threadIdx.x; asm volatile("" : "+v"(tid));
    Unit u;
#pragma unroll 1
    for (int i0 = 0; i0 < 16; i0 += 8) {
        f32x4 pv[4][4]; bool ok[4];
#pragma unroll
        for (int q = 0; q < 4; ++q) { const int i = i0 + 2 * q + (tid >> 8); ok[q] = S.next(i, u);
            const f32x4* pp = (const f32x4*)(ssq + (size_t)((ok[q] ? u.pm : 0) * BM + (tid & 255)) * 16);
#pragma unroll
            for (int j = 0; j < 4; ++j) pv[q][j] = pp[j]; }
#pragma unroll
        for (int q = 0; q < 4; ++q) { const int i = i0 + 2 * q + (tid >> 8);
            const f32x4 a = pv[q][0], b = pv[q][1], c = pv[q][2], d = pv[q][3];
            const float sm = ((a[0] + a[1]) + (a[2] + a[3])) + ((b[0] + b[1]) + (b[2] + b[3])) + ((c[0] + c[1]) + (c[2] + c[3])) + ((d[0] + d[1]) + (d[2] + d[3]));
            if (ok[q]) rstab[i * 256 + (tid & 255)] = 1.0f / sqrtf(sm * (1.0f / DM) + EPS); }
    }
    __syncthreads();
}
template <bool MIDSCALE_> struct EpiResidual {
    static constexpr bool PERM = true, MIDSCALE = MIDSCALE_;
    bf16_t* hb; float* ssq; const LAS float* rstab;
    __device__ __forceinline__ void operator()(const f32x4 (&acc)[2][2][4][2], const Unit& u, int  , int wr, int wc, int fr, int fq) const {
        const int row0 = u.pm * BM + wr * 64 + fr, col0 = u.pn * BM + wc * 32 + 8 * fq;
        u32x4 rv[2][2];
#pragma unroll
        for (int bj = 0; bj < 2; ++bj) rv[0][bj] = *(const u32x4*)(hb + (size_t)row0 * DM + col0 + bj * HALF);
#pragma unroll
        for (int g = 0; g < 8; ++g) {
            const int ai = g >> 2, m = g & 3;
            const int row = row0 + ai * HALF + m * 16; const size_t off = (size_t)row * DM + col0; float s = 0.f;
            if (g < 7) { const int g1 = g + 1; const size_t off1 = (size_t)(row0 + (g1 >> 2) * HALF + (g1 & 3) * 16) * DM + col0;
#pragma unroll
                for (int bj = 0; bj < 2; ++bj) rv[g1 & 1][bj] = *(const u32x4*)(hb + off1 + bj * HALF); }
#pragma unroll
            for (int bj = 0; bj < 2; ++bj) {
                const u32x4 r = rv[g & 1][bj]; const f32x4 a0 = acc[ai][bj][m][0], a1 = acc[ai][bj][m][1];
                u32x4 o; o.x = pk2(bf_lo(r.x) + a0[0], bf_hi(r.x) + a0[1]); o.y = pk2(bf_lo(r.y) + a0[2], bf_hi(r.y) + a0[3]);
                o.z = pk2(bf_lo(r.z) + a1[0], bf_hi(r.z) + a1[1]); o.w = pk2(bf_lo(r.w) + a1[2], bf_hi(r.w) + a1[3]);
                *(u32x4*)(hb + off + bj * HALF) = o;
#pragma unroll
                for (int e = 0; e < 4; ++e) { const float x0 = bf_lo(o[e]), x1 = bf_hi(o[e]); s += x0 * x0 + x1 * x1; }
            }
            s += __shfl_xor(s, 16); s += __shfl_xor(s, 32);
            if (fq == 0) ssq[(size_t)row * 16 + u.pn * 4 + wc] = s;
        }
    }
};

__device__ __forceinline__ void build_rs_table_mla(LAS float* rstab, const StaticOrder& S, const float* ssqm) {
    int tid = threadIdx.x; asm volatile("" : "+v"(tid));
    Unit u;
#pragma unroll 1
    for (int i0 = 0; i0 < 16; i0 += 2) {
        const int i = i0 + (tid >> 8); const bool ok = S.next(i, u);
        const f32x4 a = *(const f32x4*)(ssqm + (size_t)((ok ? u.pm : 0) * BM + (tid & 255)) * 4);
        if (ok) rstab[i * 256 + (tid & 255)] = 1.0f / sqrtf(((a[0] + a[1]) + (a[2] + a[3])) * (1.0f / 256.0f) + EPS);
        if (!S.next(i0 + 2, u)) break;
    }
    __syncthreads();
}
template <class Epi>
__device__ __forceinline__ void gemm_phase(LAS unsigned char* lds, const Gemm g, const StaticOrder& S, const Epi& E) {
    int tid = threadIdx.x; asm volatile("" : "+v"(tid));
    const int wid = __builtin_amdgcn_readfirstlane(tid >> 6), lane = tid & 63, wr = wid >> 2, wc = wid & 3, fr = lane & 15, fq = lane >> 4;
    const int K = g.K, nt = K / BK;
    unsigned voffA[2], voffB[2];
#pragma unroll
    for (int i = 0; i < 2; ++i) { int R, C; stage_rc(tid * 16 + i * 8192, R, C); const int Rb = Epi::PERM ? ((R & ~31) + perm32(R & 31)) : R;
        voffA[i] = (unsigned)(R * K + C) * 2u; voffB[i] = (unsigned)(Rb * K + C) * 2u; }
    const size_t kstep = (size_t)(BK * 2);
    const size_t hstep = (size_t)HALF * K * 2;
    const size_t tstep = 2 * hstep;
    const unsigned ldsw = (unsigned)wid * 1024u;
    const int aoff = lds_byte(wr * 64 + fr, fq * 8), boff = lds_byte(wc * 32 + fr, fq * 8);
#define PG8_SA(b, h) (((b) * 2 + (h)) * HTB)
#define PG8_SB(b, h) ((4 + (b) * 2 + (h)) * HTB)
#define PG8_STAGE(bufoff, gbase, voff) do { _Pragma("unroll") for (int _i = 0; _i < 2; ++_i) \
        __builtin_amdgcn_global_load_lds((const unsigned*)((const char*)(gbase) + (voff)[_i]), (LAS unsigned*)(lds + (bufoff) + ldsw + _i * 8192), 16, 0, 0); } while (0)
#define PG8_LDA(dst, b, h) do { _Pragma("unroll") for (int m = 0; m < 4; ++m) _Pragma("unroll") for (int k = 0; k < 2; ++k) dst[m][k] = *(const LAS bf16x8*)(lds + PG8_SA(b, h) + aoff + m * 2048 + k * 1024); } while (0)
#define PG8_LDB(dst, b, h) do { _Pragma("unroll") for (int n = 0; n < 2; ++n) _Pragma("unroll") for (int k = 0; k < 2; ++k) dst[n][k] = *(const LAS bf16x8*)(lds + PG8_SB(b, h) + boff + n * 2048 + k * 1024); } while (0)
#define PG8_MMA(ai, bj, At, Bt) do { __builtin_amdgcn_s_setprio(1); _Pragma("unroll") for (int m = 0; m < 4; ++m) _Pragma("unroll") for (int n = 0; n < 2; ++n) _Pragma("unroll") for (int k = 0; k < 2; ++k) \
        acc[ai][bj][m][n] = __builtin_amdgcn_mfma_f32_16x16x32_bf16(Bt[n][k], At[m][k], acc[ai][bj][m][n], 0, 0, 0); __builtin_amdgcn_s_setprio(0); } while (0)
#define PG8_WAIT_V(n) asm volatile("s_waitcnt vmcnt(" #n ")" ::: "memory")
#define PG8_WAIT_L(n) asm volatile("s_waitcnt lgkmcnt(" #n ")" ::: "memory")
#define PG8_BAR __builtin_amdgcn_s_barrier()
#define PG8_SCHED __builtin_amdgcn_sched_barrier(0)
    Unit cur, nxt; int ui = 0;
    if (!S.next(0, cur)) return;
    f32x4 acc[2][2][4][2];
#pragma unroll
    for (int a = 0; a < 2; ++a)
#pragma unroll
        for (int b = 0; b < 2; ++b)
#pragma unroll
            for (int m = 0; m < 4; ++m)
#pragma unroll
                for (int n = 0; n < 2; ++n) acc[a][b][m][n] = (f32x4){0.f, 0.f, 0.f, 0.f};
    bf16x8 At[4][2], B0[2][2], B1[2][2];
    const char* cA = (const char*)g.A + (size_t)cur.pm * tstep; const char* cB = (const char*)g.Bt + (size_t)cur.pn * tstep;
    PG8_STAGE(PG8_SB(0, 0), cB, voffB); PG8_STAGE(PG8_SA(0, 0), cA, voffA); PG8_STAGE(PG8_SB(0, 1), cB + hstep, voffB); PG8_STAGE(PG8_SA(0, 1), cA + hstep, voffA);
    if (wr == 1) PG8_BAR;
    PG8_WAIT_V(4); PG8_BAR;
    PG8_STAGE(PG8_SB(1, 0), cB + kstep, voffB); PG8_STAGE(PG8_SA(1, 0), cA + kstep, voffA); PG8_STAGE(PG8_SB(1, 1), cB + hstep + kstep, voffB);
    PG8_WAIT_V(6); PG8_BAR;
    for (;;) {
        const bool has_next = S.next(ui + 1, nxt);
        const char* nA = has_next ? (const char*)g.A + (size_t)nxt.pm * tstep : cA; const char* nB = has_next ? (const char*)g.Bt + (size_t)nxt.pn * tstep : cB;
        for (int t = 0; t < nt; t += 2) {
            if constexpr (Epi::MIDSCALE) {
                if (t == 4 || t == 8) {
                    float f[2][4];
#pragma unroll
                    for (int ai = 0; ai < 2; ++ai)
#pragma unroll
                        for (int m = 0; m < 4; ++m) f[ai][m] = E.rstab[ui * 256 + wr * 64 + fr + ai * HALF + m * 16];
                    asm volatile("s_waitcnt lgkmcnt(0)" ::: "memory");
#pragma unroll
                    for (int ai = 0; ai < 2; ++ai)
#pragma unroll
                        for (int m = 0; m < 4; ++m) { const float ff = (t == 4) ? __builtin_amdgcn_rcpf(f[ai][m]) : f[ai][m];
#pragma unroll
                            for (int bj = 0; bj < 2; ++bj)
#pragma unroll
                                for (int n = 0; n < 2; ++n) acc[ai][bj][m][n] = acc[ai][bj][m][n] * ff; }
                }
            }
            const bool last = (t == nt - 2);
            const char* a1 = cA + (size_t)(t + 1) * kstep;
            const char* a2 = last ? nA : cA + (size_t)(t + 2) * kstep; const char* b2 = last ? nB : cB + (size_t)(t + 2) * kstep;
            const char* a3 = a2 + kstep; const char* b3 = b2 + kstep;
            PG8_LDB(B0, 0, 0); PG8_SCHED; PG8_LDA(At, 0, 0); PG8_STAGE(PG8_SA(1, 1), a1 + hstep, voffA);
            PG8_WAIT_L(8); PG8_BAR; PG8_WAIT_L(0); PG8_MMA(0, 0, At, B0); PG8_BAR; PG8_SCHED;
            PG8_LDB(B1, 0, 1); PG8_STAGE(PG8_SB(0, 0), b2, voffB);
            PG8_BAR; PG8_WAIT_L(0); PG8_MMA(0, 1, At, B1); PG8_BAR;
            PG8_LDA(At, 0, 1); PG8_STAGE(PG8_SA(0, 0), a2, voffA);
            PG8_BAR; PG8_WAIT_L(0); PG8_MMA(1, 0, At, B0); PG8_BAR; PG8_SCHED;
            PG8_STAGE(PG8_SB(0, 1), b2 + hstep, voffB);
            PG8_WAIT_V(6); PG8_BAR; PG8_MMA(1, 1, At, B1); PG8_BAR;
            PG8_LDB(B0, 1, 0); PG8_SCHED; PG8_LDA(At, 1, 0); PG8_STAGE(PG8_SA(0, 1), a2 + hstep, voffA);
            PG8_WAIT_L(8); PG8_BAR; PG8_WAIT_L(0); PG8_MMA(0, 0, At, B0); PG8_BAR; PG8_SCHED;
            PG8_LDB(B1, 1, 1); PG8_STAGE(PG8_SB(1, 0), b3, voffB);
            PG8_BAR; PG8_WAIT_L(0); PG8_MMA(0, 1, At, B1); PG8_BAR;
            PG8_LDA(At, 1, 1); PG8_STAGE(PG8_SA(1, 0), a3, voffA);
            PG8_BAR; PG8_WAIT_L(0); PG8_MMA(1, 0, At, B0); PG8_BAR; PG8_SCHED;
            PG8_STAGE(PG8_SB(1, 1), b3 + hstep, voffB);
            PG8_WAIT_V(6); PG8_BAR; PG8_MMA(1, 1, At, B1); PG8_BAR;
        }
        E(acc, cur, ui, wr, wc, fr, fq);
        if (!has_next) break;
#pragma unroll
        for (int a = 0; a < 2; ++a)
#pragma unroll
            for (int b = 0; b < 2; ++b)
#pragma unroll
                for (int m = 0; m < 4; ++m)
#pragma unroll
                    for (int n = 0; n < 2; ++n) acc[a][b][m][n] = (f32x4){0.f, 0.f, 0.f, 0.f};
        cur = nxt; cA = nA; cB = nB; ++ui;
    }
    PG8_WAIT_V(0);
    if (wr == 0) PG8_BAR;
    PG8_BAR;
#undef PG8_SA
#undef PG8_SB
#undef PG8_STAGE
#undef PG8_LDA
#undef PG8_LDB
#undef PG8_MMA
#undef PG8_WAIT_V
#undef PG8_WAIT_L
#undef PG8_BAR
#undef PG8_SCHED
}
}

__device__ __forceinline__ void pinf8(float (&v)[32], int o) {
    asm volatile("" : "+v"(v[o]), "+v"(v[o + 1]), "+v"(v[o + 2]), "+v"(v[o + 3]), "+v"(v[o + 4]), "+v"(v[o + 5]), "+v"(v[o + 6]), "+v"(v[o + 7]));
}
__device__ __forceinline__ void transpose_item(const float* W, int N, const float* kscale, const float* nscale, bf16_t* WT, int ldk, LAS float* scr, int item, int lane) {
    const int nblk = N / 32, kb = item / nblk, nb = item % nblk, k0 = 64 * kb, n0 = 32 * nb;
    const int c = lane & 7;
    float v[32];
    const float* src = W + (size_t)(k0 + (lane >> 5)) * N + n0 + (lane & 31);
#pragma unroll
    for (int i = 0; i < 32; ++i) v[i] = src[(size_t)(2 * i) * N];
    f32x4 ks0 = (f32x4){1.f, 1.f, 1.f, 1.f}, ks1 = ks0;
    if (kscale) { ks0 = *(const f32x4*)(kscale + k0 + 8 * c); ks1 = *(const f32x4*)(kscale + k0 + 8 * c + 4); }
    float nsv[4];
#pragma unroll
    for (int j = 0; j < 4; ++j) nsv[j] = nscale ? nscale[n0 + (lane >> 3) + 8 * j] : 1.0f;
    pinf8(v, 0); pinf8(v, 8); pinf8(v, 16); pinf8(v, 24);
#pragma unroll
    for (int i = 0; i < 32; ++i) scr[(2 * i + (lane >> 5)) * 33 + (lane & 31)] = v[i];
    asm volatile("s_waitcnt lgkmcnt(0)" ::: "memory");
#pragma unroll
    for (int j = 0; j < 4; ++j) { const int n = (lane >> 3) + 8 * j; const LAS float* s = scr + (8 * c) * 33 + n; const float ns = nsv[j];
        u32x4 o; o.x = pk2(s[0 * 33] * ks0[0] * ns, s[1 * 33] * ks0[1] * ns); o.y = pk2(s[2 * 33] * ks0[2] * ns, s[3 * 33] * ks0[3] * ns);
        o.z = pk2(s[4 * 33] * ks1[0] * ns, s[5 * 33] * ks1[1] * ns); o.w = pk2(s[6 * 33] * ks1[2] * ns, s[7 * 33] * ks1[3] * ns);
        *(u32x4*)(WT + (size_t)(n0 + n) * ldk + k0 + 8 * c) = o; }
    asm volatile("s_waitcnt lgkmcnt(0)" ::: "memory");
}

__device__ __forceinline__ void phase_prologue(KP p, LAS unsigned char* lds) {
    int tid = threadIdx.x; asm volatile("" : "+v"(tid));
    const int lane = tid & 63, wave = tid >> 6;
    const int gw = blockIdx.x * 8 + wave, NGW = gridDim.x * 8;
    LAS float* scr = (LAS float*)(lds + wave * 8448);
    unsigned char* ws = p->ws;
    constexpr int I_IN = 16 * 51, I_OUT = 16 * 32, I_FF1 = 16 * 128, I_FF2 = 64 * 32, I_PW = 4 * 8, I_UQ = 3 * 12, I_UKV = 2 * 16, I_POOL = 4 * 2;
    constexpr int I_LAYER = I_IN + I_OUT + I_FF1 + I_FF2 + I_PW + I_UQ + I_UKV + I_POOL;
    for (int it = gw; it < DEPTH * I_LAYER; it += NGW) {
        const int l = it / I_LAYER; int r = it % I_LAYER;
        if (r < I_IN) { transpose_item(p->w_in + (size_t)l * DM * DIN, DIN, p->mix_norm_g + l * DM, nullptr, (bf16_t*)(ws + OFF_WIN + l * SZ_WIN), DM, scr, r, lane); continue; } r -= I_IN;
        if (r < I_OUT) { transpose_item(p->w_out + (size_t)l * DM * DM, DM, p->group_norm_g + l * DM, nullptr, (bf16_t*)(ws + OFF_WOUT + l * SZ_WOUT), DM, scr, r, lane); continue; } r -= I_OUT;
        if (r < I_FF1) { transpose_item(p->w_ff1 + (size_t)l * DM * DFF, DFF, p->ffn_norm_g + l * DM, nullptr, (bf16_t*)(ws + OFF_W1 + l * SZ_W1), DM, scr, r, lane); continue; } r -= I_FF1;
        if (r < I_FF2) { transpose_item(p->w_ff2 + (size_t)l * DFF * DM, DM, nullptr, nullptr, (bf16_t*)(ws + OFF_W2 + l * SZ_W2), DFF, scr, r, lane); continue; } r -= I_FF2;
        if (r < I_PW) { transpose_item(p->conv_pw_w + (size_t)l * 256 * 256, 256, nullptr, nullptr, (bf16_t*)(ws + OFF_PW + l * SZ_PW), 256, scr, r, lane); continue; } r -= I_PW;
        if (r < I_UQ) { transpose_item(p->mla_w_uq + (size_t)l * 192 * 384, 384, p->mla_q_norm_g + l * 192, nullptr, (bf16_t*)(ws + OFF_UQ + l * SZ_UQ), 192, scr, r, lane); continue; } r -= I_UQ;
        if (r < I_UKV) { transpose_item(p->mla_w_ukv + (size_t)l * 128 * 512, 512, p->mla_kv_norm_g + l * 128, nullptr, (bf16_t*)(ws + OFF_UKV + l * SZ_UKV), 128, scr, r, lane); continue; } r -= I_UKV;
        { const int g = r >> 1, sub = r & 1;
          transpose_item(p->pool_w + (size_t)(l * 4 + g) * 64 * 64, 64, nullptr, p->pool_scale + l * 256 + g * 64, (bf16_t*)(ws + OFF_POOL + l * SZ_POOL) + g * 64 * 64, 64, scr, sub, lane); }
    }
    const int gt = blockIdx.x * 512 + tid, NGT = gridDim.x * 512;
    for (int i = gt; i < DEPTH * 160 * (DM / 8); i += NGT) { const int l = i / (160 * 128), r = i % (160 * 128);
        *(u32x4*)((bf16_t*)(ws + OFF_WIN + l * SZ_WIN) + (size_t)(DIN + r / 128) * DM + (r % 128) * 8) = (u32x4){0u, 0u, 0u, 0u}; }
    for (int i = gt; i < DEPTH * 4 * 128 * 128 / 2; i += NGT) { const int e = 2 * i, jj = e & 127, ii = (e >> 7) & 127; const f32x2 v = *(const f32x2*)(p->gmlp_ws + e);
        *(unsigned*)((bf16_t*)(ws + OFF_GWS) + e) = pk2(jj <= ii ? v[0] : 0.f, (jj + 1) <= ii ? v[1] : 0.f); }
    for (int i = gt; i < M_TOK * 16; i += NGT) { const int row = i >> 4, k = i & 15; const float ang = (float)p->positions[row] * INV_FREQ[k];
        const double a = (double)ang; const double n = rint(a * 0.15915494309189535); const float rr = (float)(a - n * 6.283185307179586);
        float* rt = (float*)(ws + OFF_ROPE) + (size_t)row * 32; rt[k] = cosf(rr); rt[16 + k] = sinf(rr); }
    for (int r4 = gw; r4 < M_TOK / 4; r4 += NGW) {
        u32x4 xv[16];
#pragma unroll
        for (int q = 0; q < 4; ++q)
#pragma unroll
            for (int j = 0; j < 4; ++j) xv[4 * q + j] = *((const u32x4*)(p->x + (size_t)(4 * r4 + q) * DM) + lane + 64 * j);
        pin(xv);
        float sv[4];
#pragma unroll
        for (int q = 0; q < 4; ++q) {
            u32x2* hr = (u32x2*)((bf16_t*)(ws + OFF_HB) + (size_t)(4 * r4 + q) * DM) + lane; float s = 0.f;
#pragma unroll
            for (int j = 0; j < 4; ++j) { const f32x4 v = __builtin_bit_cast(f32x4, xv[4 * q + j]); s += (v[0] * v[0] + v[1] * v[1]) + (v[2] * v[2] + v[3] * v[3]); u32x2 w2; w2.x = pk2(v[0], v[1]); w2.y = pk2(v[2], v[3]); hr[64 * j] = w2; }
            sv[q] = s;
        }
#pragma unroll
        for (int o = 1; o < 64; o <<= 1)
#pragma unroll
            for (int q = 0; q < 4; ++q) sv[q] += __shfl_xor(sv[q], o);
        const float mine = (lane >> 4) == 0 ? sv[0] : ((lane >> 4) == 1 ? sv[1] : ((lane >> 4) == 2 ? sv[2] : sv[3]));
        ((float*)(ws + OFF_SSQA))[(size_t)(4 * r4) * 16 + lane] = (lane & 15) == 0 ? mine : 0.f;
    }
}

constexpr int R1_BYTES = 88064, R2_OFF = R1_BYTES, R2_BYTES = 67584, R3_OFF = R2_OFF + R2_BYTES;
constexpr int YLD = 264, CQLD = 200, CKLD = 136, VLD = 136, CK_OFF = 128 * CQLD * 2, RS_OFF = CK_OFF + 128 * CKLD * 2;
static_assert(RS_OFF + 1024 <= R1_BYTES && R3_OFF + 8192 <= LDS_BYTES, "mixer LDS map");

template <int NKS, int NNT>
__device__ __forceinline__ void wgemm(f32x4 (&acc)[8][NNT], const LAS bf16_t* A, const int lda, const bf16_t* Bp, const int ldb) {
    u32x4 bf[NNT][NKS];
#pragma unroll
    for (int nt = 0; nt < NNT; ++nt) ldfr(bf[nt], Bp + (size_t)(16 * nt) * ldb);
#pragma unroll
    for (int nt = 0; nt < NNT; ++nt) pin(bf[nt]);
#pragma unroll
    for (int mt = 0; mt < 8; ++mt) {
        bf16x8 af[NKS];
#pragma unroll
        for (int ks = 0; ks < NKS; ++ks) af[ks] = *(const LAS bf16x8*)(A + (16 * mt) * lda + 32 * ks);
#pragma unroll
        for (int nt = 0; nt < NNT; ++nt) { f32x4 a = (f32x4){0.f, 0.f, 0.f, 0.f};
#pragma unroll
            for (int ks = 0; ks < NKS; ++ks) a = mfma16(as_bf16x8(bf[nt][ks]), af[ks], a);
            acc[mt][nt] = a; }
    }
}
template <int NNT>
__device__ __forceinline__ void part_sumsq(const f32x4 (&acc)[8][NNT], LAS float* part, int w, int fr, int fq) {
#pragma unroll
    for (int mt = 0; mt < 8; ++mt) { float s = 0.f;
#pragma unroll
        for (int nt = 0; nt < NNT; ++nt) s += (acc[mt][nt][0] * acc[mt][nt][0] + acc[mt][nt][1] * acc[mt][nt][1]) + (acc[mt][nt][2] * acc[mt][nt][2] + acc[mt][nt][3] * acc[mt][nt][3]);
        s += __shfl_xor(s, 16); s += __shfl_xor(s, 32);
        if (fq == 0) part[(16 * mt + fr) * 8 + w] = s; }
}
template <int NNT>
__device__ __forceinline__ void norm_store(const f32x4 (&acc)[8][NNT], const LAS float* part, bf16_t* dst, int fr) {
#pragma unroll
    for (int mt = 0; mt < 8; ++mt) {
        const LAS f32x4* pp = (const LAS f32x4*)(part + (16 * mt + fr) * 8); const f32x4 a = pp[0], b = pp[1];
        const float rs = rsq((((a[0] + a[1]) + (a[2] + a[3])) + ((b[0] + b[1]) + (b[2] + b[3]))) * (1.0f / 256.0f) + EPS);
#pragma unroll
        for (int nt = 0; nt < NNT; ++nt) { u32x2 o; o.x = pk2(acc[mt][nt][0] * rs, acc[mt][nt][1] * rs); o.y = pk2(acc[mt][nt][2] * rs, acc[mt][nt][3] * rs);
            *(u32x2*)(dst + (size_t)(16 * mt) * DM + 16 * nt) = o; }
    }
}

__device__ __forceinline__ void mixer_chunk(KP p, LAS unsigned char* lds, int l, int chunk) {
    int tid = threadIdx.x; asm volatile("" : "+v"(tid));
    const int lane = tid & 63, w = __builtin_amdgcn_readfirstlane(tid >> 6), fr = lane & 15, fq = lane >> 4;
    unsigned char* ws = p->ws;
    const bf16_t* zb = (const bf16_t*)(ws + OFF_ZB);
    bf16_t* mixed = (bf16_t*)(ws + OFF_MIX);
    const int c0 = chunk * 128, bidx = chunk >> 5, s0 = (chunk & 31) * 128;
    LAS bf16_t* Y = (LAS bf16_t*)lds; LAS bf16_t* CO = (LAS bf16_t*)(lds + R2_OFF); LAS bf16_t* VT = (LAS bf16_t*)lds;
    LAS bf16_t* CQ = (LAS bf16_t*)lds; LAS bf16_t* CK = (LAS bf16_t*)(lds + CK_OFF); LAS float* RSQ = (LAS float*)(lds + RS_OFF); LAS float* RSK = RSQ + 128;
    LAS bf16_t* ZP = (LAS bf16_t*)lds; LAS bf16_t* YP = (LAS bf16_t*)(lds + R2_OFF);
    LAS float* part0 = (LAS float*)(lds + R3_OFF); LAS float* part1 = part0 + 1024;
    bf16_t* mrow = mixed + (size_t)(c0 + fr) * DM + 4 * fq;

#pragma unroll 1
    for (int half = 0; half < 2; ++half) {
        u32x4 av[5], gv[5];
#pragma unroll
        for (int i = 0; i < 5; ++i) {
            const int q = tid + 512 * (5 * half + i); int r = q >> 5; r = r < 158 ? r : 157; const int cc = (q & 31) * 8;
            const int rr = (s0 - 30 + r >= 0) ? (c0 - 30 + r) : c0;
            const bf16_t* zq = zb + (size_t)rr * DIN_P + cc; av[i] = *(const u32x4*)zq; gv[i] = *(const u32x4*)(zq + ZC_G);
        }
        pin(av); pin(gv);
#pragma unroll
        for (int i = 0; i < 5; ++i) {
            const int q = tid + 512 * (5 * half + i); const int r = q >> 5, cc = (q & 31) * 8;
            u32x4 o;
#pragma unroll
            for (int e = 0; e < 4; ++e) o[e] = pk2(bf_lo(av[i][e]) * sigmoidf_(bf_lo(gv[i][e])), bf_hi(av[i][e]) * sigmoidf_(bf_hi(gv[i][e])));
            if (s0 - 30 + r < 0) o = (u32x4){0u, 0u, 0u, 0u};
            if (r < 158) *(LAS u32x4*)(Y + r * YLD + cc) = o;
        }
    }
    __syncthreads();
    {
        const int hc = w & 1, tq = w >> 1, c = 128 * hc + 2 * lane;
        const float* dw = p->conv_dw_w + (size_t)l * 31 * 256 + c;
        float w0[31], w1[31];
#pragma unroll
        for (int j = 0; j < 31; ++j) { const f32x2 ww = *(const f32x2*)(dw + j * 256); w0[j] = ww[0]; w1[j] = ww[1]; }
        const f32x2 bb = *(const f32x2*)(p->conv_dw_b + l * 256 + c);
#pragma unroll 1
        for (int blk = 0; blk < 4; ++blk) {
            const int t0 = 32 * tq + 8 * blk;
            float a0[8], a1[8];
#pragma unroll
            for (int o = 0; o < 8; ++o) { a0[o] = bb[0]; a1[o] = bb[1]; }
#pragma unroll
            for (int r = 0; r < 38; ++r) {
                const unsigned yv = *(const LAS unsigned*)(Y + (t0 + r) * YLD + c); const float y0 = bf_lo(yv), y1 = bf_hi(yv);
#pragma unroll
                for (int o = 0; o < 8; ++o) { const int j = r - o; if (j >= 0 && j <= 30) { a0[o] += w0[j] * y0; a1[o] += w1[j] * y1; } }
            }
#pragma unroll
            for (int o = 0; o < 8; ++o) *(LAS unsigned*)(CO + (t0 + o) * YLD + c) = pk2(a0[o], a1[o]);
        }
    }
    __syncthreads();
    u32x4 sq[6], sk[4];
#pragma unroll
    for (int i = 0; i < 6; ++i) { const int q = tid + 512 * i, r = q / 24, pc = q % 24; sq[i] = *(const u32x4*)(zb + (size_t)(c0 + r) * DIN_P + ZC_CQ + 8 * pc); }
#pragma unroll
    for (int i = 0; i < 4; ++i) { const int q = tid + 512 * i, r = q >> 4, pc = q & 15; sk[i] = *(const u32x4*)(zb + (size_t)(c0 + r) * DIN_P + ZC_CKV + 8 * pc); }
    {
        const f32x4 lg = *(const f32x4*)(p->conv_ln_g + l * 256 + 4 * lane), lb = *(const f32x4*)(p->conv_ln_b + l * 256 + 4 * lane);
#pragma unroll 1
        for (int half = 0; half < 2; ++half) {
            f32x4 x[8]; float s[8];
#pragma unroll
            for (int i = 0; i < 8; ++i) { const u32x2 v = *(const LAS u32x2*)(CO + (16 * w + 8 * half + i) * YLD + 4 * lane);
                x[i] = (f32x4){bf_lo(v.x), bf_hi(v.x), bf_lo(v.y), bf_hi(v.y)}; s[i] = (x[i][0] + x[i][1]) + (x[i][2] + x[i][3]); }
#pragma unroll
            for (int o = 1; o < 64; o <<= 1)
#pragma unroll
                for (int i = 0; i < 8; ++i) s[i] += __shfl_xor(s[i], o);
#pragma unroll
            for (int i = 0; i < 8; ++i) { x[i] = x[i] - s[i] * (1.0f / 256.0f); s[i] = (x[i][0] * x[i][0] + x[i][1] * x[i][1]) + (x[i][2] * x[i][2] + x[i][3] * x[i][3]); }
#pragma unroll
            for (int o = 1; o < 64; o <<= 1)
#pragma unroll
                for (int i = 0; i < 8; ++i) s[i] += __shfl_xor(s[i], o);
#pragma unroll
            for (int i = 0; i < 8; ++i) {
                const float rstd = rsq(s[i] * (1.0f / 256.0f) + EPS);
                f32x4 y = x[i] * rstd * lg + lb;
#pragma unroll
                for (int j = 0; j < 4; ++j) y[j] = y[j] * sigmoidf_(y[j]);
                u32x2 o; o.x = pk2(y[0], y[1]); o.y = pk2(y[2], y[3]); *(LAS u32x2*)(CO + (16 * w + 8 * half + i) * YLD + 4 * lane) = o;
            }
        }
    }
    pin(sq); pin(sk);
#pragma unroll
    for (int i = 0; i < 6; ++i) { const int q = tid + 512 * i, r = q / 24, pc = q % 24; *(LAS u32x4*)(CQ + r * CQLD + 8 * pc) = sq[i]; }
#pragma unroll
    for (int i = 0; i < 4; ++i) { const int q = tid + 512 * i, r = q >> 4, pc = q & 15; *(LAS u32x4*)(CK + r * CKLD + 8 * pc) = sk[i]; }
    __syncthreads();
    f32x4 accc[8][2];
    wgemm<8, 2>(accc, CO + fr * YLD + 8 * fq, YLD, (const bf16_t*)(ws + OFF_PW + l * SZ_PW) + (size_t)(32 * w + fr) * 256 + 8 * fq, 256);
    part_sumsq<2>(accc, part0, w, fr, fq);
    {
        float ssq_ = 0.f, ssk = 0.f;
#pragma unroll
        for (int ks = 0; ks < 6; ++ks) ssq_ += sumsq8(*(const LAS u32x4*)(CQ + (16 * w + fr) * CQLD + 32 * ks + 8 * fq));
#pragma unroll
        for (int ks = 0; ks < 4; ++ks) ssk += sumsq8(*(const LAS u32x4*)(CK + (16 * w + fr) * CKLD + 32 * ks + 8 * fq));
        ssq_ += __shfl_xor(ssq_, 16); ssq_ += __shfl_xor(ssq_, 32); ssk += __shfl_xor(ssk, 16); ssk += __shfl_xor(ssk, 32);
        if (fq == 0) { RSQ[16 * w + fr] = QSCALE * rsq(ssq_ * (1.0f / 192.0f) + EPS); RSK[16 * w + fr] = rsq(ssk * (1.0f / 128.0f) + EPS); }
        const int row = c0 + 16 * w + fr, spos = s0 + 16 * w + fr;
        const bf16_t* zr = zb + (size_t)row * DIN_P; const float* rt = (const float*)(ws + OFF_ROPE) + (size_t)row * 32;
        const u32x2 r1 = *(const u32x2*)(zr + ZC_KR + 4 * fq), r2 = *(const u32x2*)(zr + ZC_KR + 16 + 4 * fq);
        const f32x4 cs = *(const f32x4*)(rt + 4 * fq), sn = *(const f32x4*)(rt + 16 + 4 * fq);
        const f32x4 k1 = (f32x4){bf_lo(r1.x), bf_hi(r1.x), bf_lo(r1.y), bf_hi(r1.y)}, k2 = (f32x4){bf_lo(r2.x), bf_hi(r2.x), bf_lo(r2.y), bf_hi(r2.y)};
        const f32x4 o1 = k1 * cs - k2 * sn, o2 = k2 * cs + k1 * sn;
        u32x2 ro1, ro2; ro1.x = pk2(o1[0], o1[1]); ro1.y = pk2(o1[2], o1[3]); ro2.x = pk2(o2[0], o2[1]); ro2.y = pk2(o2[2], o2[3]);
        bf16_t* kd = (bf16_t*)(ws + OFF_K) + ((size_t)(bidx * 4) * SEQ + spos) * 96 + 64 + 4 * fq;
#pragma unroll
        for (int h = 0; h < 4; ++h) { *(u32x2*)(kd + (size_t)h * SEQ * 96) = ro1; *(u32x2*)(kd + (size_t)h * SEQ * 96 + 16) = ro2; }
    }
    __syncthreads();
    norm_store<2>(accc, part0, mrow + 0 + 32 * w, fr);
    {
        f32x4 acc[8][3];
        wgemm<6, 3>(acc, CQ + fr * CQLD + 8 * fq, CQLD, (const bf16_t*)(ws + OFF_UQ + l * SZ_UQ) + (size_t)(48 * w + fr) * 192 + 8 * fq, 192);
        const int head = (3 * w) / 6, d0 = 16 * ((3 * w) % 6);
        u32x4 csn[16];
        if (w & 1) {
#pragma unroll
            for (int mt = 0; mt < 8; ++mt) { const float* rt = (const float*)(ws + OFF_ROPE) + (size_t)(c0 + 16 * mt + fr) * 32 + 4 * fq; csn[2 * mt] = *(const u32x4*)rt; csn[2 * mt + 1] = *(const u32x4*)(rt + 16); }
            pin(csn);
        }
#pragma unroll
        for (int mt = 0; mt < 8; ++mt) {
            const float rs = RSQ[16 * mt + fr];
            f32x4 a0 = acc[mt][0] * rs, a1 = acc[mt][1] * rs, a2 = acc[mt][2] * rs;
            if (w & 1) { const f32x4 cs = __builtin_bit_cast(f32x4, csn[2 * mt]), sn = __builtin_bit_cast(f32x4, csn[2 * mt + 1]); const f32x4 x1 = a1, x2 = a2; a1 = x1 * cs - x2 * sn; a2 = x2 * cs + x1 * sn; }
            bf16_t* qd = (bf16_t*)(ws + OFF_Q) + ((size_t)(bidx * 4 + head) * SEQ + s0 + 16 * mt + fr) * 96 + d0 + 4 * fq;
            u32x2 o; o.x = pk2(a0[0], a0[1]); o.y = pk2(a0[2], a0[3]); *(u32x2*)(qd) = o;
            o.x = pk2(a1[0], a1[1]); o.y = pk2(a1[2], a1[3]); *(u32x2*)(qd + 16) = o;
            o.x = pk2(a2[0], a2[1]); o.y = pk2(a2[2], a2[3]); *(u32x2*)(qd + 32) = o;
        }
    }
#pragma unroll 1
    for (int pz = 0; pz < 2; ++pz) {
        f32x4 acc[8][2];
        wgemm<4, 2>(acc, CK + fr * CKLD + 8 * fq, CKLD, (const bf16_t*)(ws + OFF_UKV + l * SZ_UKV) + (size_t)(64 * w + 32 * pz + fr) * 128 + 8 * fq, 128);
        const int head = w >> 1;
#pragma unroll
        for (int mt = 0; mt < 8; ++mt) {
            const float rs = RSK[16 * mt + fr]; const int spos = s0 + 16 * mt + fr;
#pragma unroll
            for (int n = 0; n < 2; ++n) {
                const f32x4 a = acc[mt][n] * rs; const unsigned p0 = pk2(a[0], a[1]), p1 = pk2(a[2], a[3]);
                if ((w & 1) == 0) { u32x2 o; o.x = p0; o.y = p1; *(u32x2*)((bf16_t*)(ws + OFF_K) + ((size_t)(bidx * 4 + head) * SEQ + spos) * 96 + 16 * (2 * pz + n) + 4 * fq) = o; }
                else { const int fp = ((fr & 4) << 1) | ((fr & 8) >> 1) | (fr & 3);
                    bf16_t* vv = (bf16_t*)(ws + OFF_VT) + ((size_t)(bidx * 4 + head) * 64 + 16 * (2 * pz + n) + 4 * fq) * SEQ + (spos - fr + fp);
                    vv[0] = (bf16_t)(p0 & 0xffff); vv[SEQ] = (bf16_t)(p0 >> 16); vv[2 * SEQ] = (bf16_t)(p1 & 0xffff); vv[3 * SEQ] = (bf16_t)(p1 >> 16); }
            }
        }
    }
    __syncthreads();
    {
        u32x4 zv[9];
#pragma unroll
        for (int i = 0; i < 9; ++i) { int q = tid + 512 * i; q = q < 143 * 32 ? q : 143 * 32 - 1; const int r = q >> 5, pc = q & 31; const int rr = (s0 - 15 + r >= 0) ? (c0 - 15 + r) : c0;
            zv[i] = *(const u32x4*)(zb + (size_t)rr * DIN_P + ZC_POOL + 8 * pc); }
        { u32x4 (&z8)[8] = *(u32x4 (*)[8])&zv[0]; pin(z8); }
#pragma unroll
        for (int i = 0; i < 9; ++i) { const int q = tid + 512 * i; if (q < 143 * 32) *(LAS u32x4*)(ZP + (q >> 5) * YLD + 8 * (q & 31)) = zv[i]; }
    }
    __syncthreads();
#pragma unroll
    for (int i = 0; i < 8; ++i) {
        const int g = i & 3, W = 2 << g, idx = tid + 512 * (i >> 2), r = idx >> 3, pc = 8 * g + (idx & 7);
        const int spos = s0 + r; const int cnt = (spos + 1) < W ? (spos + 1) : W; const float inv = 1.0f / (float)cnt;
        const LAS bf16_t* zp = ZP + (r + 15) * YLD + 8 * pc;
        float sum[8];
#pragma unroll
        for (int e = 0; e < 8; ++e) sum[e] = 0.f;
        const u32x4 self = *(const LAS u32x4*)zp;
#pragma unroll
        for (int j = 0; j < W; ++j) { const u32x4 v = *(const LAS u32x4*)(zp - j * YLD); const float m = j < cnt ? 1.f : 0.f;
#pragma unroll
            for (int e = 0; e < 4; ++e) { sum[2 * e] += m * bf_lo(v[e]); sum[2 * e + 1] += m * bf_hi(v[e]); } }
        u32x4 yv;
#pragma unroll
        for (int e = 0; e < 4; ++e) yv[e] = pk2(sum[2 * e] * inv - bf_lo(self[e]), sum[2 * e + 1] * inv - bf_hi(self[e]));
        *(LAS u32x4*)(YP + r * YLD + 8 * pc) = yv;
    }
    u32x4 vv[8];
    {
        const bf16_t* vr = zb + (size_t)(c0 + 16 * w + (lane >> 2)) * DIN_P + ZC_V + 64 * (lane & 3);
#pragma unroll
        for (int i = 0; i < 8; ++i) vv[i] = *(const u32x4*)(vr + 8 * i);
    }
    __syncthreads();
    f32x4 accp[8][2];
    {
        const int g = w >> 1, t0 = 2 * (w & 1);
        wgemm<2, 2>(accp, YP + fr * YLD + 64 * g + 8 * fq, YLD, (const bf16_t*)(ws + OFF_POOL + l * SZ_POOL) + (size_t)(64 * g + 16 * t0 + fr) * 64 + 8 * fq, 64);
        part_sumsq<2>(accp, part1, w, fr, fq);
    }
    {
        pin(vv);
        const int j = 16 * w + (lane >> 2), q4 = lane & 3; float ss = 0.f;
#pragma unroll
        for (int i = 0; i < 8; ++i) ss += sumsq8(vv[i]);
        ss += __shfl_xor(ss, 1); ss += __shfl_xor(ss, 2);
        const float rs = rsq(ss * (1.0f / 256.0f) + EPS);
        const float* gg = p->gmlp_norm_g + l * 256 + 64 * q4;
#pragma unroll
        for (int i = 0; i < 8; ++i) {
            const f32x4 g0 = *(const f32x4*)(gg + 8 * i), g1 = *(const f32x4*)(gg + 8 * i + 4);
#pragma unroll
            for (int e = 0; e < 4; ++e) { const int d = 8 * i + 2 * e; const float ga = e < 2 ? g0[2 * e] : g1[2 * e - 4], gb = e < 2 ? g0[2 * e + 1] : g1[2 * e - 3];
                const unsigned pk = pk2(bf_lo(vv[i][e]) * rs * ga, bf_hi(vv[i][e]) * rs * gb);
                VT[(64 * q4 + d) * VLD + j] = (bf16_t)(pk & 0xffff); VT[(64 * q4 + d + 1) * VLD + j] = (bf16_t)(pk >> 16); }
        }
    }
    __syncthreads();
    norm_store<2>(accp, part1, mrow + 512 + 64 * (w >> 1) + 32 * (w & 1), fr);
    {
        const int h = w >> 1, t0 = 2 * (w & 1);
        bf16x8 vf[2][4];
#pragma unroll
        for (int n = 0; n < 2; ++n)
#pragma unroll
            for (int ks = 0; ks < 4; ++ks) vf[n][ks] = *(const LAS bf16x8*)(VT + (64 * h + 16 * (t0 + n) + fr) * VLD + 32 * ks + 8 * fq);
        const bf16_t* gwp = (const bf16_t*)(ws + OFF_GWS + l * SZ_GWS) + (size_t)(h * 128 + fr) * 128 + 8 * fq;
        u32x2 uu[16]; float bias[8];
#pragma unroll
        for (int mt = 0; mt < 8; ++mt) {
            bias[mt] = p->gmlp_bs[(l * 4 + h) * 128 + 16 * mt + fr];
#pragma unroll
            for (int n = 0; n < 2; ++n) uu[2 * mt + n] = *(const u32x2*)(zb + (size_t)(c0 + 16 * mt + fr) * DIN_P + ZC_U + 64 * h + 16 * (t0 + n) + 4 * fq);
        }
        f32x4 acc[8][2];
#pragma unroll
        for (int mp = 0; mp < 4; ++mp) {
            u32x4 wf[8];
#pragma unroll
            for (int q = 0; q < 2; ++q)
#pragma unroll
                for (int ks = 0; ks < 4; ++ks) wf[4 * q + ks] = *(const u32x4*)(gwp + (size_t)(16 * (2 * mp + q)) * 128 + 32 * (ks <= mp ? ks : 0));
            pin(wf);
#pragma unroll
            for (int q = 0; q < 2; ++q)
#pragma unroll
                for (int n = 0; n < 2; ++n) { f32x4 a = (f32x4){0.f, 0.f, 0.f, 0.f};
#pragma unroll
                    for (int ks = 0; ks < 4; ++ks) if (ks <= mp) a = mfma16(vf[n][ks], as_bf16x8(wf[4 * q + ks]), a);
                    const int mt = 2 * mp + q; const u32x2 u2 = uu[2 * mt + n]; const float bs_ = bias[mt];
                    a[0] = bf_lo(u2.x) * (a[0] + bs_); a[1] = bf_hi(u2.x) * (a[1] + bs_); a[2] = bf_lo(u2.y) * (a[2] + bs_); a[3] = bf_hi(u2.y) * (a[3] + bs_);
                    acc[mt][n] = a; }
        }
        part_sumsq<2>(acc, part0, w, fr, fq);
        __syncthreads();
        norm_store<2>(acc, part0, mrow + 768 + 64 * h + 16 * t0, fr);
    }
    __syncthreads();
}

constexpr int KLD = 104, VSLD = 136, KS_BYTES = 128 * KLD * 2, VS_BYTES = 64 * VSLD * 2, KV_BUF = KS_BYTES + VS_BYTES;

__device__ __forceinline__ void attn_block(KP p, LAS unsigned char* lds, int bh, int q0) {
    int tid = threadIdx.x; asm volatile("" : "+v"(tid));
    const int lane = tid & 63, w = __builtin_amdgcn_readfirstlane(tid >> 6), lr = lane & 31, lh = lane >> 5;
    unsigned char* ws = p->ws;
    const bf16_t* Qg = (const bf16_t*)(ws + OFF_Q) + (size_t)bh * SEQ * 96;
    const bf16_t* Kg = (const bf16_t*)(ws + OFF_K) + (size_t)bh * SEQ * 96;
    const bf16_t* Vg = (const bf16_t*)(ws + OFF_VT) + (size_t)bh * 64 * SEQ;
    const int qrow = q0 + 32 * w + lr, wave_q0 = q0 + 32 * w;
    bf16x8 qf[6];
#pragma unroll
    for (int ks = 0; ks < 6; ++ks) qf[ks] = *(const bf16x8*)(Qg + (size_t)qrow * 96 + 16 * ks + 8 * lh);
    f32x16 o0, o1;
#pragma unroll
    for (int i = 0; i < 16; ++i) { o0[i] = 0.f; o1[i] = 0.f; }
    float mrun = -1e30f, lrun = 0.f;
    const int nst = (q0 + 256) / 128;
    u32x4 rk[3], rv[2];
#pragma unroll
    for (int i = 0; i < 3; ++i) { const int q = tid + 512 * i; rk[i] = *(const u32x4*)(Kg + (size_t)(q / 12) * 96 + 8 * (q % 12)); }
#pragma unroll
    for (int i = 0; i < 2; ++i) { const int q = tid + 512 * i; rv[i] = *(const u32x4*)(Vg + (size_t)(q >> 4) * SEQ + 8 * (q & 15)); }
    for (int st = 0; st < nst; ++st) {
        LAS bf16_t* ksm0 = (LAS bf16_t*)(lds + (st & 1) * KV_BUF); LAS bf16_t* vsm0 = (LAS bf16_t*)(lds + (st & 1) * KV_BUF + KS_BYTES);
#pragma unroll
        for (int i = 0; i < 3; ++i) { const int q = tid + 512 * i; *(LAS u32x4*)(ksm0 + (q / 12) * KLD + 8 * (q % 12)) = rk[i]; }
#pragma unroll
        for (int i = 0; i < 2; ++i) { const int q = tid + 512 * i; *(LAS u32x4*)(vsm0 + (q >> 4) * VSLD + 8 * (q & 15)) = rv[i]; }
        if (st + 1 < nst) {
            const int k1 = 128 * (st + 1);
#pragma unroll
            for (int i = 0; i < 3; ++i) { const int q = tid + 512 * i; rk[i] = *(const u32x4*)(Kg + (size_t)(k1 + q / 12) * 96 + 8 * (q % 12)); }
#pragma unroll
            for (int i = 0; i < 2; ++i) { const int q = tid + 512 * i; rv[i] = *(const u32x4*)(Vg + (size_t)(q >> 4) * SEQ + k1 + 8 * (q & 15)); }
        }
        __syncthreads();
#pragma unroll
        for (int sub = 0; sub < 2; ++sub) {
        const int kt = 2 * st + sub;
        const LAS bf16_t* ksm = ksm0 + 64 * sub * KLD; const LAS bf16_t* vsm = vsm0 + 64 * sub;
        if (64 * kt <= wave_q0 + 31) {
            f32x16 s0, s1;
#pragma unroll
            for (int i = 0; i < 16; ++i) { s0[i] = 0.f; s1[i] = 0.f; }
            u32x4 ka[6], kb[6];
#pragma unroll
            for (int ks = 0; ks < 6; ++ks) { ka[ks] = *(const LAS u32x4*)(ksm + lr * KLD + 16 * ks + 8 * lh); kb[ks] = *(const LAS u32x4*)(ksm + (32 + lr) * KLD + 16 * ks + 8 * lh); }
            pin(ka); pin(kb);
#pragma unroll
            for (int ks = 0; ks < 6; ++ks) { s0 = mfma32(as_bf16x8(ka[ks]), qf[ks], s0); s1 = mfma32(as_bf16x8(kb[ks]), qf[ks], s1); }
            u32x4 va[4], vb[4];
#pragma unroll
            for (int q = 0; q < 4; ++q) { const LAS bf16_t* vp = vsm + lr * VSLD + 16 * q + 8 * lh; va[q] = *(const LAS u32x4*)vp; vb[q] = *(const LAS u32x4*)(vp + 32 * VSLD); }
            if (64 * kt + 63 > wave_q0) {
#pragma unroll
                for (int i = 0; i < 16; ++i) { const int key = 64 * kt + (i & 3) + 8 * (i >> 2) + 4 * lh;
                    if (key > qrow) s0[i] = -1e30f; if (key + 32 > qrow) s1[i] = -1e30f; }
            }
            float mx = s0[0];
#pragma unroll
            for (int i = 1; i < 16; ++i) mx = fmaxf(mx, s0[i]);
#pragma unroll
            for (int i = 0; i < 16; ++i) mx = fmaxf(mx, s1[i]);
            mx = fmaxf(mx, __shfl_xor(mx, 32));
            if (__builtin_amdgcn_ballot_w64(mx > mrun) != 0ull) {
                const float mnew = fmaxf(mrun, mx), alpha = fast_exp2(mrun - mnew);
                lrun *= alpha; mrun = mnew; o0 = o0 * alpha; o1 = o1 * alpha;
            }
            float rsum = 0.f;
#pragma unroll
            for (int i = 0; i < 16; ++i) { s0[i] = fast_exp2(s0[i] - mrun); s1[i] = fast_exp2(s1[i] - mrun); rsum += s0[i] + s1[i]; }
            lrun += rsum;
            pin(va); pin(vb);
#pragma unroll
            for (int q = 0; q < 4; ++q) {
                u32x4 pw;
#pragma unroll
                for (int e = 0; e < 4; ++e) pw[e] = (q >> 1) == 0 ? pk2(s0[8 * (q & 1) + 2 * e], s0[8 * (q & 1) + 2 * e + 1]) : pk2(s1[8 * (q & 1) + 2 * e], s1[8 * (q & 1) + 2 * e + 1]);
                const bf16x8 pf = as_bf16x8(pw);
                o0 = mfma32(as_bf16x8(va[q]), pf, o0); o1 = mfma32(as_bf16x8(vb[q]), pf, o1);
            }
        }
        }
    }
    const float ltot = lrun + __shfl_xor(lrun, 32), inv = fast_rcp(ltot);
    o0 = o0 * inv; o1 = o1 * inv;
    float ss = 0.f;
#pragma unroll
    for (int i = 0; i < 16; ++i) ss += o0[i] * o0[i] + o1[i] * o1[i];
    ss += __shfl_xor(ss, 32);
    const int b = bh >> 2, hd = bh & 3; const size_t grow = (size_t)b * SEQ + qrow;
    if (lh == 0) ((float*)(ws + OFF_SSQM))[grow * 4 + hd] = ss;
    bf16_t* od = (bf16_t*)(ws + OFF_MIX) + grow * DM + 256 + 64 * hd + 4 * lh;
#pragma unroll
    for (int g = 0; g < 4; ++g) {
        u32x2 a, c; a.x = pk2(o0[4 * g], o0[4 * g + 1]); a.y = pk2(o0[4 * g + 2], o0[4 * g + 3]); c.x = pk2(o1[4 * g], o1[4 * g + 1]); c.y = pk2(o1[4 * g + 2], o1[4 * g + 3]);
        *(u32x2*)(od + 8 * g) = a; *(u32x2*)(od + 32 + 8 * g) = c;
    }
    __syncthreads();
}


#define XB_TMO      128
#define XB_XCNT(j)  (256  + 64 * (j))
#define XB_XSUB(j)  (1280 + 64 * (j))
#define XB_XGEN(j)  (2304 + 64 * (j))
#define XB_TOP      3328
#define XB_TOPGEN   3392
#define XB_SPIN_CAP (1u << 20)
__device__ __forceinline__ unsigned xb_ld(unsigned* p)              { return __hip_atomic_load(p, __ATOMIC_RELAXED, __HIP_MEMORY_SCOPE_AGENT); }
__device__ __forceinline__ unsigned xb_add(unsigned* p, unsigned v) { return __hip_atomic_fetch_add(p, v, __ATOMIC_RELAXED, __HIP_MEMORY_SCOPE_AGENT); }
__device__ __forceinline__ unsigned xb_xcc_id() { return (unsigned)__builtin_amdgcn_s_getreg((3 << 11) | 20) & 0xFu; }
#define XB_SPIN(cond, bar) do { unsigned _sp = 0; while (cond) { __builtin_amdgcn_s_sleep(1); \
    if ((++_sp & 255u) == 0u) { if (xb_ld(&(bar)[XB_TMO])) break; if (_sp > XB_SPIN_CAP) { atomicAdd(&(bar)[XB_TMO], 1u); break; } } } } while (0)
__device__ __forceinline__ void xb_complete(unsigned* bar, unsigned x, unsigned& nloc, unsigned& nx) {
    const unsigned G = gridDim.x;
    unsigned sum, cnt, mine, sp = 0u;
    for (;;) {
        sum = 0u; cnt = 0u; mine = 0u;
#pragma unroll
        for (unsigned j = 0; j < 16; ++j) { const unsigned c = xb_ld(&bar[XB_XCNT(j)]); sum += c; cnt += (c > 0u) ? 1u : 0u; mine = (j == x) ? c : mine; }
        if (sum == G) break;
        __builtin_amdgcn_s_sleep(1);
        if ((++sp & 255u) == 0u) { if (xb_ld(&bar[XB_TMO])) break; if (sp > XB_SPIN_CAP) { atomicAdd(&bar[XB_TMO], 1u); break; } }
    }
    nloc = mine > 0u ? mine : 1u; nx = cnt > 0u ? cnt : 1u;
}
__device__ __forceinline__ void grid_barrier(unsigned* bar, const unsigned x, unsigned& nloc, unsigned& nx) {
    asm volatile("s_waitcnt vmcnt(0) lgkmcnt(0)" ::: "memory");
    __syncthreads();
    if (threadIdx.x == 0) {
        __builtin_amdgcn_s_waitcnt(0);
        if (nloc == 0u) xb_complete(bar, x, nloc, nx);
        const unsigned old = xb_add(&bar[XB_XSUB(x)], 1u);
        const unsigned gen = old / nloc;
        if (old + 1u == (gen + 1u) * nloc) {
            __builtin_amdgcn_fence(__ATOMIC_RELEASE, "agent");
            asm volatile("s_waitcnt vmcnt(0)" ::: "memory");
            const unsigned og = xb_add(&bar[XB_TOP], 1u);
            const unsigned tg = og / nx;
            if (og + 1u == (tg + 1u) * nx) xb_add(&bar[XB_TOPGEN], 1u);
            else XB_SPIN(xb_ld(&bar[XB_TOPGEN]) == tg, bar);
            __builtin_amdgcn_fence(__ATOMIC_ACQUIRE, "agent");
            xb_add(&bar[XB_XGEN(x)], 1u);
            asm volatile("s_waitcnt vmcnt(0)" ::: "memory");
        } else {
            XB_SPIN(xb_ld(&bar[XB_XGEN(x)]) == gen, bar);
            __builtin_amdgcn_fence(__ATOMIC_ACQUIRE, "agent");
            asm volatile("s_waitcnt vmcnt(0)" ::: "memory");
        }
    }
    __syncthreads();
    nloc = __builtin_amdgcn_readfirstlane(nloc); nx = __builtin_amdgcn_readfirstlane(nx);
}

__global__ void __launch_bounds__(512) fwd_kernel(Params p_arg) {
    extern __shared__ __attribute__((aligned(16))) unsigned char smem[];
    LAS unsigned char* lds = (LAS unsigned char*)smem;
    cg::grid_group grid = cg::this_grid();
    const int ph_lo = p_arg.ph_lo, ph_hi = p_arg.ph_hi;
    unsigned nbar = 0;
    unsigned* const xbar = (unsigned*)(p_arg.ws + OFF_BAR); const unsigned xcc = xb_xcc_id(); unsigned xb_nloc = 0u, xb_nx = 0u;
    if (threadIdx.x == 0) (void)xb_add(&xbar[XB_XCNT(xcc)], 1u);
    if (ph_lo < 0) grid.sync();
    for (int ph = ph_lo; ph < ph_hi; ++ph)
    for (int rep = 0; rep < 1 + ((DUP_MASK >> (ph == 0 ? 0 : (ph == 1 + 7 * DEPTH ? 31 : 1 + (ph - 1) % 7))) & 1); ++rep) {
        if (ph >= 1 && ph < 1 + 7 * DEPTH && (ph - 1) % 7 == 3) continue;
        if (ph > ph_lo || rep > 0) {
            ++nbar;
            grid_barrier(xbar, xcc, xb_nloc, xb_nx);
        }
        KP p = (KP)__builtin_amdgcn_kernarg_segment_ptr();
        asm volatile("" : "+s"(p));
        unsigned char* ws = p->ws;
        int tid = threadIdx.x; asm volatile("" : "+v"(tid));
        const int lane = tid & 63, wave = tid >> 6;
        const int gw = blockIdx.x * 8 + wave, NGW = gridDim.x * 8;
        if (ph == 0) {
#if PH_MASK & 1
 phase_prologue(p, lds);
#endif
 continue; }
        if (ph == 1 + 7 * DEPTH) {
            const float* ssq = (const float*)(ws + OFF_SSQA);
            for (int r4 = gw; r4 < M_TOK / 4; r4 += NGW) {
                u32x4 xv[8];
#pragma unroll
                for (int q = 0; q < 4; ++q)
#pragma unroll
                    for (int j = 0; j < 2; ++j) xv[2 * q + j] = *((const u32x4*)((const bf16_t*)(ws + OFF_HB) + (size_t)(4 * r4 + q) * DM) + lane + 64 * j);
                float sp = ssq[(size_t)(4 * r4) * 16 + lane];
                pin(xv);
                sp += __shfl_xor(sp, 1); sp += __shfl_xor(sp, 2); sp += __shfl_xor(sp, 4); sp += __shfl_xor(sp, 8);
                const float rsl = rsq(sp * (1.0f / DM) + EPS);
#pragma unroll
                for (int q = 0; q < 4; ++q) {
                    const float rs = __shfl(rsl, 16 * q);
#pragma unroll
                    for (int j = 0; j < 2; ++j) {
                        const f32x4* gg = (const f32x4*)(p->final_norm_g + 512 * j + 8 * lane); const f32x4 g0 = gg[0], g1 = gg[1]; const u32x4 v = xv[2 * q + j];
                        f32x4* orow = (f32x4*)(p->out + (size_t)(4 * r4 + q) * DM + 512 * j + 8 * lane);
                        orow[0] = (f32x4){bf_lo(v.x) * rs * g0[0], bf_hi(v.x) * rs * g0[1], bf_lo(v.y) * rs * g0[2], bf_hi(v.y) * rs * g0[3]};
                        orow[1] = (f32x4){bf_lo(v.z) * rs * g1[0], bf_hi(v.z) * rs * g1[1], bf_lo(v.w) * rs * g1[2], bf_hi(v.w) * rs * g1[3]};
                    }
                }
            }
            continue;
        }
        const int l = (ph - 1) / 7, sub = (ph - 1) % 7;
        pg8::StaticOrder S;
#if PH_MASK & 2
        if (sub == 0) {
            pg8::Gemm g{(const bf16_t*)(ws + OFF_HB), (const bf16_t*)(ws + OFF_WIN + l * SZ_WIN), M_TOK, DIN_P, DM};
            S.init(M_TOK, DIN_P, gridDim.x, blockIdx.x);
            LAS float* rstab = (LAS float*)(lds + pg8::STAGE_BYTES);
            pg8::build_rs_table(rstab, S, (const float*)(ws + OFF_SSQA));
            pg8::EpiScaleBf16<0> E{(bf16_t*)(ws + OFF_ZB), DIN_P, rstab};
            pg8::gemm_phase(lds, g, S, E);
        } else
#endif
#if PH_MASK & 4
        if (sub == 1) {
            for (int ch = blockIdx.x; ch < M_TOK / 128; ch += gridDim.x) mixer_chunk(p, lds, l, ch);
        } else
#endif
#if PH_MASK & 8
        if (sub == 2) {
            for (int it0 = blockIdx.x; it0 < 256; it0 += gridDim.x) { const int it = (it0 & 7) * 32 + (it0 >> 3);
                const int bh = it >> 3, pr = it & 7; attn_block(p, lds, bh, 256 * pr); attn_block(p, lds, bh, 256 * (15 - pr)); }
        } else
#endif
        if (sub == 3) {
            const float* sm = (const float*)(ws + OFF_SSQM); bf16_t* mixed = (bf16_t*)(ws + OFF_MIX);
            for (int r8 = gw; r8 < M_TOK / 8; r8 += NGW) {
                u32x4 mv[4]; f32x4 s4[4];
#pragma unroll
                for (int q = 0; q < 4; ++q) { const int row = 8 * r8 + 2 * q + (lane >> 5); s4[q] = *(const f32x4*)(sm + (size_t)row * 4); mv[q] = *(const u32x4*)(mixed + (size_t)row * DM + 256 + 8 * (lane & 31)); }
                pin(mv);
#pragma unroll
                for (int q = 0; q < 4; ++q) { const int row = 8 * r8 + 2 * q + (lane >> 5);
                    const float rs = rsq(((s4[q][0] + s4[q][1]) + (s4[q][2] + s4[q][3])) * (1.0f / 256.0f) + EPS); u32x4 v = mv[q];
#pragma unroll
                    for (int e = 0; e < 4; ++e) v[e] = pk2(bf_lo(v[e]) * rs, bf_hi(v[e]) * rs);
                    *(u32x4*)(mixed + (size_t)row * DM + 256 + 8 * (lane & 31)) = v; }
            }
        } else
#if PH_MASK & 16
        if (sub == 4) {
            pg8::Gemm g{(const bf16_t*)(ws + OFF_MIX), (const bf16_t*)(ws + OFF_WOUT + l * SZ_WOUT), M_TOK, DM, DM};
            S.init(M_TOK, DM, gridDim.x, blockIdx.x);
            LAS float* rstab = (LAS float*)(lds + pg8::STAGE_BYTES);
            pg8::build_rs_table_mla(rstab, S, (const float*)(ws + OFF_SSQM));
            pg8::EpiResidual<true> E{(bf16_t*)(ws + OFF_HB), (float*)(ws + OFF_SSQF), rstab};
            pg8::gemm_phase(lds, g, S, E);
        } else
#endif
#if PH_MASK & 32
        if (sub == 5) {
            pg8::Gemm g{(const bf16_t*)(ws + OFF_HB), (const bf16_t*)(ws + OFF_W1 + l * SZ_W1), M_TOK, DFF, DM};
            S.init(M_TOK, DFF, gridDim.x, blockIdx.x);
            LAS float* rstab = (LAS float*)(lds + pg8::STAGE_BYTES);
            pg8::build_rs_table(rstab, S, (const float*)(ws + OFF_SSQF));
            pg8::EpiScaleBf16<1> E{(bf16_t*)(ws + OFF_FB), DFF, rstab};
            pg8::gemm_phase(lds, g, S, E);
        } else
#endif
#if PH_MASK & 64
        if (sub == 6) {
            pg8::Gemm g{(const bf16_t*)(ws + OFF_FB), (const bf16_t*)(ws + OFF_W2 + l * SZ_W2), M_TOK, DM, DFF};
            S.init(M_TOK, DM, gridDim.x, blockIdx.x);
            pg8::EpiResidual<false> E{(bf16_t*)(ws + OFF_HB), (float*)(ws + OFF_SSQA), nullptr};
            pg8::gemm_phase(lds, g, S, E);
        }
#endif
        {}
    }
}

#ifndef N_LAUNCH_MODE
#define N_LAUNCH_MODE 0
#endif

extern "C" void kernel_launch(void* const* d_in, const int* in_sizes, int n_in, void* d_out, int out_size, void* d_ws, size_t ws_size, hipStream_t stream) {
    static int grid = 0;
    if (grid == 0) {
        if (n_in != 24 || ws_size < WS_TOTAL) { fprintf(stderr, "kernel_launch: unexpected n_in %d / ws_size %zu (need %zu)\n", n_in, ws_size, (size_t)WS_TOTAL); grid = -1; return; }
        int dev = 0, cus = 0, per_cu = 0;
        hipGetDevice(&dev); hipDeviceGetAttribute(&cus, hipDeviceAttributeMultiprocessorCount, dev);
        if (hipFuncSetAttribute((const void*)fwd_kernel, hipFuncAttributeMaxDynamicSharedMemorySize, LDS_BYTES) != hipSuccess) { fprintf(stderr, "kernel_launch: hipFuncSetAttribute failed\n"); grid = -1; return; }
        if (hipOccupancyMaxActiveBlocksPerMultiprocessor(&per_cu, (const void*)fwd_kernel, 512, LDS_BYTES) != hipSuccess || per_cu < 1) { fprintf(stderr, "kernel_launch: occupancy query says %d\n", per_cu); per_cu = 1; }
        (void)hipGetLastError();
        grid = cus * 1;
    }
    if (grid < 0) return;
    Params p{};
    p.x = (const float*)d_in[0]; p.positions = (const int*)d_in[1]; p.mix_norm_g = (const float*)d_in[2]; p.w_in = (const float*)d_in[3]; p.conv_dw_w = (const float*)d_in[4];
    p.conv_dw_b = (const float*)d_in[5]; p.conv_ln_g = (const float*)d_in[6]; p.conv_ln_b = (const float*)d_in[7]; p.conv_pw_w = (const float*)d_in[8]; p.mla_q_norm_g = (const float*)d_in[9];
    p.mla_w_uq = (const float*)d_in[10]; p.mla_kv_norm_g = (const float*)d_in[11]; p.mla_w_ukv = (const float*)d_in[12]; p.pool_w = (const float*)d_in[13]; p.pool_scale = (const float*)d_in[14];
    p.gmlp_norm_g = (const float*)d_in[15]; p.gmlp_ws = (const float*)d_in[16]; p.gmlp_bs = (const float*)d_in[17]; p.group_norm_g = (const float*)d_in[18]; p.w_out = (const float*)d_in[19];
    p.ffn_norm_g = (const float*)d_in[20]; p.w_ff1 = (const float*)d_in[21]; p.w_ff2 = (const float*)d_in[22]; p.final_norm_g = (const float*)d_in[23];
    p.out = (float*)d_out; p.ws = (unsigned char*)d_ws;
    constexpr int NPH = 2 + 7 * DEPTH;
#if N_LAUNCH_MODE == 0
    p.ph_lo = 0; p.ph_hi = NPH;
    (void)hipMemsetAsync((unsigned char*)d_ws + OFF_BAR, 0, 16384, stream);
    void* args[] = {&p};
    hipError_t e = hipLaunchCooperativeKernel((const void*)fwd_kernel, dim3(grid), dim3(512), args, LDS_BYTES, stream);
    if (e != hipSuccess) fprintf(stderr, "cooperative launch failed: %s (grid %d)\n", hipGetErrorString(e), grid);
#else
    for (int ph = 0; ph < NPH; ++ph) { p.ph_lo = ph; p.ph_hi = ph + 1; hipLaunchKernelGGL(fwd_kernel, dim3(grid), dim3(512), LDS_BYTES, stream, p); }
#endif
}
```
